# Optimizing an MI355X kernel written in HIP

```python
import jax, jax.numpy as jnp
from jax import lax
import numpy as np

D_MODEL = 2048
BATCH = 32
SEQ = 256
DEPTH = 4
DEC_BATCH = 4
DEC_SEQ = 2048
PAST_LEN = 256

GRID_W = 64
HEAD_DIM = 128
N_HEADS_A = 8
N_KV_A = 2
N_HEADS_B = 8
NOPE_B = 128
ROPE_B = 64
VDIM_B = 128
KV_RANK = 256
D_FF = ((8 * D_MODEL + 3 * 256 - 1) // (3 * 256)) * 256
Q_BLOCK = 128
ROPE_THETA = 10000.0
EPS = 1e-6

W_QA = N_HEADS_A * HEAD_DIM
W_KA = N_KV_A * HEAD_DIM
W_QB = N_HEADS_B * (NOPE_B + ROPE_B)
IN_COLS = W_QA + 2 * W_KA + W_QB + KV_RANK + ROPE_B
D_MIX = N_HEADS_A * HEAD_DIM + N_HEADS_B * VDIM_B

kernel_name = "hybrid_gqa_mla_diffusion_step"


def rmsnorm(x, g):
    xf = x.astype(jnp.float32)
    y = xf * lax.rsqrt(jnp.mean(xf * xf, axis=-1, keepdims=True) + EPS)
    return (y * g.astype(jnp.float32)).astype(x.dtype)


def grid_angles(n_tokens, dim):
    n_rows = n_tokens // GRID_W
    row = jnp.repeat(jnp.arange(n_rows, dtype=jnp.float32), GRID_W)
    col = jnp.tile(jnp.arange(GRID_W, dtype=jnp.float32), n_rows)
    n_freq = dim // 4
    inv = ROPE_THETA ** (-jnp.arange(n_freq, dtype=jnp.float32) / n_freq)
    ang = jnp.concatenate([row[:, None] * inv, col[:, None] * inv], axis=-1)
    return jnp.cos(ang), jnp.sin(ang)


def apply_rope(x, cos, sin):
    xf = x.astype(jnp.float32)
    half = x.shape[-1] // 2
    x1, x2 = xf[..., :half], xf[..., half:]
    cs, sn = cos[None, :, None, :], sin[None, :, None, :]
    return jnp.concatenate([x1 * cs - x2 * sn, x2 * cs + x1 * sn], axis=-1).astype(x.dtype)


def attention(q, k, v):
    B, Lq, H, dq = q.shape
    Hk, dv = k.shape[2], v.shape[-1]
    G = H // Hk
    nb = Lq // Q_BLOCK
    qb = q.reshape(B, nb, Q_BLOCK, Hk, G, dq).transpose(1, 0, 2, 3, 4, 5)
    kf = k.astype(jnp.float32)
    vf = v.astype(jnp.float32)
    scale = dq ** -0.5

    def one_block(qblk):
        s = jnp.einsum('bqhgd,bkhd->bhgqk', qblk.astype(jnp.float32), kf) * scale
        p = jax.nn.softmax(s, axis=-1)
        return jnp.einsum('bhgqk,bkhe->bqhge', p, vf)

    out = lax.map(one_block, qb)
    return out.transpose(1, 0, 2, 3, 4, 5).reshape(B, Lq, H, dv).astype(q.dtype)


def project(h, w_in_l, qnorm_l, knorm_l, kvnorm_l):
    B, L, _ = h.shape
    p = jnp.einsum('bld,de->ble', h, w_in_l)
    o1 = W_QA
    o2 = o1 + W_KA
    o3 = o2 + W_KA
    o4 = o3 + W_QB
    o5 = o4 + KV_RANK
    q_a = rmsnorm(p[..., :o1].reshape(B, L, N_HEADS_A, HEAD_DIM), qnorm_l)
    k_a = rmsnorm(p[..., o1:o2].reshape(B, L, N_KV_A, HEAD_DIM), knorm_l)
    v_a = p[..., o2:o3].reshape(B, L, N_KV_A, HEAD_DIM)
    q_b = p[..., o3:o4].reshape(B, L, N_HEADS_B, NOPE_B + ROPE_B)
    ckv = rmsnorm(p[..., o4:o5], kvnorm_l)
    krope = p[..., o5:]
    return q_a, k_a, v_a, q_b, ckv, krope


def mla_expand(ckv, krope, w_uk_l, w_uv_l):
    B, L, _ = ckv.shape
    k_nope = jnp.einsum('blr,rn->bln', ckv, w_uk_l).reshape(B, L, N_HEADS_B, NOPE_B)
    v = jnp.einsum('blr,rn->bln', ckv, w_uv_l).reshape(B, L, N_HEADS_B, VDIM_B)
    k_r = jnp.broadcast_to(krope[:, :, None, :], (B, L, N_HEADS_B, ROPE_B))
    return jnp.concatenate([k_nope, k_r], axis=-1), v


def mix_out(o_a, o_b, w_o_l):
    B, L = o_a.shape[:2]
    o = jnp.concatenate([o_a.reshape(B, L, -1), o_b.reshape(B, L, -1)], axis=-1)
    return jnp.einsum('ble,ed->bld', o, w_o_l)


def swiglu(h, wg, wu, wd):
    a = jnp.einsum('bld,df->blf', h, wg)
    b = jnp.einsum('bld,df->blf', h, wu)
    return jnp.einsum('blf,fd->bld', jax.nn.silu(a) * b, wd)


def modulate(x, shift, scale):
    return x * (1 + scale) + shift


def setup_inputs(seed: int = 0) -> dict:
    key = jax.random.key(seed)
    ks = jax.random.split(key, 24)
    f32 = jnp.float32
    nrm = lambda k, shape, s: jax.random.normal(k, shape, f32) * s
    return {
        "x_prompt": nrm(ks[0], (BATCH, SEQ, D_MODEL), 1.0),
        "x_sample": nrm(ks[1], (DEC_BATCH, DEC_SEQ, D_MODEL), 1.0),
        "cache_k_a": nrm(ks[2], (DEC_BATCH, DEPTH, PAST_LEN, N_KV_A, HEAD_DIM), 1.0),
        "cache_v_a": nrm(ks[3], (DEC_BATCH, DEPTH, PAST_LEN, N_KV_A, HEAD_DIM), 1.0),
        "cache_ckv_b": nrm(ks[4], (DEC_BATCH, DEPTH, PAST_LEN, KV_RANK), 1.0),
        "cache_krope_b": nrm(ks[5], (DEC_BATCH, DEPTH, PAST_LEN, ROPE_B), 1.0),
        "c": nrm(ks[6], (DEC_BATCH, D_MODEL), 1.0),
        "c_ctx": nrm(ks[7], (D_MODEL,), 1.0),
        "w_ada": nrm(ks[8], (DEPTH, D_MODEL, 6 * D_MODEL), 0.5 * D_MODEL ** -0.5),
        "b_ada": nrm(ks[9], (DEPTH, 6 * D_MODEL), 0.02),
        "norm_attn": 1.0 + nrm(ks[10], (DEPTH, D_MODEL), 0.02),
        "norm_ffn": 1.0 + nrm(ks[11], (DEPTH, D_MODEL), 0.02),
        "w_in": nrm(ks[12], (DEPTH, D_MODEL, IN_COLS), D_MODEL ** -0.5),
        "qnorm_a": 1.0 + nrm(ks[13], (DEPTH, HEAD_DIM), 0.02),
        "knorm_a": 1.0 + nrm(ks[14], (DEPTH, HEAD_DIM), 0.02),
        "kvnorm_b": 1.0 + nrm(ks[15], (DEPTH, KV_RANK), 0.02),
        "w_uk_b": nrm(ks[16], (DEPTH, KV_RANK, N_HEADS_B * NOPE_B), KV_RANK ** -0.5),
        "w_uv_b": nrm(ks[17], (DEPTH, KV_RANK, N_HEADS_B * VDIM_B), KV_RANK ** -0.5),
        "w_o": nrm(ks[18], (DEPTH, D_MIX, D_MODEL), D_MIX ** -0.5),
        "w_gate": nrm(ks[19], (DEPTH, D_MODEL, D_FF), D_MODEL ** -0.5),
        "w_up": nrm(ks[20], (DEPTH, D_MODEL, D_FF), D_MODEL ** -0.5),
        "w_down": nrm(ks[21], (DEPTH, D_FF, D_MODEL), D_FF ** -0.5),
        "norm_final": 1.0 + nrm(ks[22], (D_MODEL,), 0.02),
    }


def reference(x_prompt, x_sample, cache_k_a, cache_v_a, cache_ckv_b, cache_krope_b, c,
              c_ctx, w_ada, b_ada, norm_attn, norm_ffn, w_in, qnorm_a, knorm_a, kvnorm_b,
              w_uk_b, w_uv_b, w_o, w_gate, w_up, w_down, norm_final):
    xp = x_prompt
    xs = x_sample
    cos_a, sin_a = grid_angles(xs.shape[1], HEAD_DIM)
    cos_b, sin_b = grid_angles(xs.shape[1], ROPE_B)
    silu_ctx = jax.nn.silu(c_ctx)
    silu_c = jax.nn.silu(c)
    ks_a, vs_a, ckvs_b, kropes_b = [], [], [], []

    for l in range(DEPTH):
        mc = jnp.einsum('d,de->e', silu_ctx, w_ada[l]) + b_ada[l]
        sh1, sc1, g1, sh2, sc2, g2 = jnp.split(mc, 6, axis=-1)
        h = modulate(rmsnorm(xp, norm_attn[l]), sh1, sc1)
        q_a, k_a, v_a, q_b, ckv, krope = project(h, w_in[l], qnorm_a[l], knorm_a[l], kvnorm_b[l])
        k_b, v_b = mla_expand(ckv, krope, w_uk_b[l], w_uv_b[l])
        o_a = attention(q_a, k_a, v_a)
        o_b = attention(q_b, k_b, v_b)
        xp = xp + g1 * mix_out(o_a, o_b, w_o[l])
        h = modulate(rmsnorm(xp, norm_ffn[l]), sh2, sc2)
        xp = xp + g2 * swiglu(h, w_gate[l], w_up[l], w_down[l])
        ks_a.append(k_a)
        vs_a.append(v_a)
        ckvs_b.append(ckv)
        kropes_b.append(krope)

        ms = (jnp.einsum('bd,de->be', silu_c, w_ada[l]) + b_ada[l])[:, None, :]
        sh1, sc1, g1, sh2, sc2, g2 = jnp.split(ms, 6, axis=-1)
        h = modulate(rmsnorm(xs, norm_attn[l]), sh1, sc1)
        q_a, k_a, v_a, q_b, ckv, krope = project(h, w_in[l], qnorm_a[l], knorm_a[l], kvnorm_b[l])
        q_a = apply_rope(q_a, cos_a, sin_a)
        k_a = apply_rope(k_a, cos_a, sin_a)
        q_b = jnp.concatenate([q_b[..., :NOPE_B], apply_rope(q_b[..., NOPE_B:], cos_b, sin_b)], axis=-1)
        krope = apply_rope(krope[:, :, None, :], cos_b, sin_b)[:, :, 0, :]
        k_a_all = jnp.concatenate([cache_k_a[:, l], k_a], axis=1)
        v_a_all = jnp.concatenate([cache_v_a[:, l], v_a], axis=1)
        ckv_all = jnp.concatenate([cache_ckv_b[:, l], ckv], axis=1)
        krope_all = jnp.concatenate([cache_krope_b[:, l], krope], axis=1)
        k_b, v_b = mla_expand(ckv_all, krope_all, w_uk_b[l], w_uv_b[l])
        o_a = attention(q_a, k_a_all, v_a_all)
        o_b = attention(q_b, k_b, v_b)
        xs = xs + g1 * mix_out(o_a, o_b, w_o[l])
        h = modulate(rmsnorm(xs, norm_ffn[l]), sh2, sc2)
        xs = xs + g2 * swiglu(h, w_gate[l], w_up[l], w_down[l])

    y_prompt = rmsnorm(xp, norm_final)
    y_sample = rmsnorm(xs, norm_final)
    new_k_a = jnp.stack(ks_a, axis=1)
    new_v_a = jnp.stack(vs_a, axis=1)
    new_ckv_b = jnp.stack(ckvs_b, axis=1)
    new_krope_b = jnp.stack(kropes_b, axis=1)
    return (y_prompt, y_sample, new_k_a, new_v_a, new_ckv_b, new_krope_b)
```

```cpp
#include <hip/hip_runtime.h>
#include <cstdio>
#include <cstdint>


namespace pg8 {
#define PG8_LAS __attribute__((address_space(3)))
typedef unsigned short bf16_t;
typedef short bf16x8 __attribute__((ext_vector_type(8)));
typedef float f32x4 __attribute__((ext_vector_type(4)));
typedef unsigned u32x4 __attribute__((ext_vector_type(4)));
typedef int pg8_i32x4 __attribute__((ext_vector_type(4)));
constexpr int BM = 256, BK = 64, HALF = 128, HTB = HALF * BK * 2  , STAGE_BYTES = 8 * HTB, NXCD = 8, WGM = 8;

__host__ __device__ __forceinline__ int lds_byte(int r, int c) { const int st = (r >> 4) * 2 + (c >> 5), rr = r & 15, cc = c & 31, ob = rr * 64 + cc * 2; return st * 1024 + (ob ^ (((ob >> 9) & 1) << 5)); }
__host__ __device__ __forceinline__ void stage_rc(int b, int& R, int& C) { const int st = b / 1024, sb = b % 1024, swz = sb ^ (((sb >> 9) & 1) << 5); R = (st >> 1) * 16 + swz / 64; C = (st & 1) * 32 + (swz % 64) / 2; }
__host__ __device__ __forceinline__ int perm32(int rho) { const int n = rho >> 4, i = rho & 15; return 8 * (i >> 2) + 4 * n + (i & 3); }

struct Unit { int pm, pn; };
struct Gemm { const bf16_t* A; const bf16_t* Bt; int M, N, K; };

struct StaticOrder {
    int nM, nN, nwg, G, c;
    __host__ __device__ void init(int M, int N, int G_, int c_) { nM = M / BM; nN = N / BM; nwg = nM * nN; G = G_; c = c_; }
    __host__ __device__ bool next(int i, Unit& u) const {
        const long L = (long)i * G + c; if (L >= nwg) return false;
        int wgid = (int)L; { const int q = nwg / NXCD, r = nwg % NXCD, xcd = wgid % NXCD, off = wgid / NXCD; wgid = (xcd < r ? xcd * (q + 1) : r * (q + 1) + (xcd - r) * q) + off; }
        const int nig = WGM * nN, gid = wgid / nig, fm = gid * WGM, gsz = (nM - fm) < WGM ? (nM - fm) : WGM;
        u.pm = fm + ((wgid % nig) % gsz); u.pn = (wgid % nig) / gsz; return true;
    }
    __device__ __forceinline__ void a_ready(const Unit&) const {}
    __device__ __forceinline__ void done(const Unit&) const {}
};

__device__ __forceinline__ unsigned cvt_pk_bf16(float lo, float hi) { unsigned r; asm volatile("v_cvt_pk_bf16_f32 %0, %1, %2" : "=v"(r) : "v"(lo), "v"(hi)); return r; }
typedef float f32x2 __attribute__((ext_vector_type(2)));


typedef unsigned u32x2 __attribute__((ext_vector_type(2)));
struct EpiBf16Split {
    static constexpr bool PERM = true, AFTER_DRAIN = false;
    bf16_t* O; int ldc; int split_cols; size_t split_stride;
    __device__ __forceinline__ void operator()(const f32x4 (&acc)[2][2][4][2], const Unit& u, int wr, int wc, int fr, int fq) const {
        { int t_ = threadIdx.x; asm volatile("" : "+v"(t_)); fr = t_ & 15; fq = (t_ >> 4) & 3; }
        const int row0 = u.pm * BM + wr * 64 + fr; int colt = u.pn * BM; bf16_t* base = O;
        if (split_cols) { const int t = colt / split_cols; base += (size_t)t * split_stride; colt -= t * split_cols; }
        const int col0 = colt + wc * 32 + 8 * fq;
#pragma unroll
        for (int ai = 0; ai < 2; ++ai)
#pragma unroll
            for (int m = 0; m < 4; ++m) { bf16_t* rowp = base + (size_t)(row0 + ai * HALF + m * 16) * ldc + col0;
#pragma unroll
                for (int bj = 0; bj < 2; ++bj) { const f32x4 v0 = acc[ai][bj][m][0], v1 = acc[ai][bj][m][1];
                    u32x4 w; w.x = cvt_pk_bf16(v0[0], v0[1]); w.y = cvt_pk_bf16(v0[2], v0[3]); w.z = cvt_pk_bf16(v1[0], v1[1]); w.w = cvt_pk_bf16(v1[2], v1[3]);
                    *(u32x4*)(rowp + bj * HALF) = w; } }
    }
};

struct EpiRes {
    static constexpr bool PERM = true, AFTER_DRAIN = false;
    bf16_t* X; const float* gate;
    __device__ __forceinline__ void operator()(const f32x4 (&acc)[2][2][4][2], const Unit& u, int wr, int wc, int fr, int fq) const {
        { int t_ = threadIdx.x; asm volatile("" : "+v"(t_)); fr = t_ & 15; fq = (t_ >> 4) & 3; }
        const int grp = u.pm < 32 ? 0 : 1 + ((u.pm - 32) >> 3);
        const int col0 = u.pn * BM + wc * 32 + 8 * fq;
        const float* gv = gate + (size_t)grp * 12288 + col0;
        f32x4 g[2][2];
#pragma unroll
        for (int bj = 0; bj < 2; ++bj)
#pragma unroll
            for (int n = 0; n < 2; ++n) g[bj][n] = *(const f32x4*)(gv + bj * HALF + 4 * n);
        u32x4 xr[2][4][2];
#pragma unroll
        for (int ai = 0; ai < 2; ++ai)
#pragma unroll
            for (int m = 0; m < 4; ++m) { const bf16_t* xp = X + (size_t)(u.pm * BM + ai * HALF + wr * 64 + m * 16 + fr) * 2048 + col0;
#pragma unroll
                for (int bj = 0; bj < 2; ++bj) xr[ai][m][bj] = *(const u32x4*)(xp + bj * HALF); }
#pragma unroll
        for (int ai = 0; ai < 2; ++ai)
#pragma unroll
            for (int m = 0; m < 4; ++m) { bf16_t* xp = X + (size_t)(u.pm * BM + ai * HALF + wr * 64 + m * 16 + fr) * 2048 + col0;
#pragma unroll
                for (int bj = 0; bj < 2; ++bj) { const u32x4 r = xr[ai][m][bj];
                    f32x4 x0 = (f32x4){__uint_as_float(r.x << 16), __uint_as_float(r.x & 0xffff0000u), __uint_as_float(r.y << 16), __uint_as_float(r.y & 0xffff0000u)};
                    f32x4 x1 = (f32x4){__uint_as_float(r.z << 16), __uint_as_float(r.z & 0xffff0000u), __uint_as_float(r.w << 16), __uint_as_float(r.w & 0xffff0000u)};
                    x0 = x0 + g[bj][0] * acc[ai][bj][m][0]; x1 = x1 + g[bj][1] * acc[ai][bj][m][1];
                    u32x4 w; w.x = cvt_pk_bf16(x0[0], x0[1]); w.y = cvt_pk_bf16(x0[2], x0[3]); w.z = cvt_pk_bf16(x1[0], x1[1]); w.w = cvt_pk_bf16(x1[2], x1[3]);
                    *(u32x4*)(xp + bj * HALF) = w; } }
    }
};

struct EpiSwiglu {
    static constexpr bool PERM = true, AFTER_DRAIN = false;
    bf16_t* H;
    __device__ __forceinline__ void operator()(const f32x4 (&acc)[2][2][4][2], const Unit& u, int wr, int wc, int fr, int fq) const {
        { int t_ = threadIdx.x; asm volatile("" : "+v"(t_)); fr = t_ & 15; fq = (t_ >> 4) & 3; }
        const int f0 = u.pn * 128 + wc * 32 + 8 * fq;
#pragma unroll
        for (int ai = 0; ai < 2; ++ai)
#pragma unroll
            for (int m = 0; m < 4; ++m) { bf16_t* rowp = H + (size_t)(u.pm * BM + ai * HALF + wr * 64 + m * 16 + fr) * 5632 + f0;
                float h[2][4];
#pragma unroll
                for (int n = 0; n < 2; ++n) { const f32x4 a = acc[ai][0][m][n], b = acc[ai][1][m][n];
#pragma unroll
                    for (int e = 0; e < 4; ++e) h[n][e] = a[e] * __builtin_amdgcn_rcpf(1.0f + __builtin_amdgcn_exp2f(a[e] * -1.4426950408889634f)) * b[e]; }
                u32x4 w; w.x = cvt_pk_bf16(h[0][0], h[0][1]); w.y = cvt_pk_bf16(h[0][2], h[0][3]); w.z = cvt_pk_bf16(h[1][0], h[1][1]); w.w = cvt_pk_bf16(h[1][2], h[1][3]);
                *(u32x4*)rowp = w; }
    }
};

struct EpiUkv {
    static constexpr bool PERM = true, AFTER_DRAIN = false;
    unsigned char* K8; unsigned char* V8;
    __device__ __forceinline__ void operator()(const f32x4 (&acc)[2][2][4][2], const Unit& u, int wr, int wc, int fr, int fq) const {
        { int t_ = threadIdx.x; asm volatile("" : "+v"(t_)); fr = t_ & 15; fq = (t_ >> 4) & 3; }
        const int row0 = u.pm * BM + wr * 64 + fr, col0 = (u.pn & 3) * BM + wc * 32 + 8 * fq;
        unsigned char* dst = u.pn < 4 ? K8 : V8;
#pragma unroll
        for (int ai = 0; ai < 2; ++ai)
#pragma unroll
            for (int m = 0; m < 4; ++m) { const size_t ro = (size_t)(row0 + ai * HALF + m * 16) * 1024 + col0;
#pragma unroll
                for (int bj = 0; bj < 2; ++bj) { const f32x4 v0 = acc[ai][bj][m][0], v1 = acc[ai][bj][m][1];
                    int lo = __builtin_amdgcn_cvt_pk_fp8_f32(v0[0], v0[1], 0, false); lo = __builtin_amdgcn_cvt_pk_fp8_f32(v0[2], v0[3], lo, true);
                    int hi = __builtin_amdgcn_cvt_pk_fp8_f32(v1[0], v1[1], 0, false); hi = __builtin_amdgcn_cvt_pk_fp8_f32(v1[2], v1[3], hi, true);
                    *(u32x2*)(dst + ro + bj * HALF) = (u32x2){(unsigned)lo, (unsigned)hi}; } }
    }
};

struct InOrderB {
    int x, w;
    __device__ __forceinline__ bool next(int i, Unit& u) const {
        if (i >= 1) return false;
        if (w < 24) { u.pm = 8 * x + (w & 7); const int g = w >> 3; u.pn = g == 0 ? 4 : (g == 1 ? 12 : 13); return true; }
        u.pm = 8 * x + (w - 24); u.pn = 11; return true;
    }
    __device__ __forceinline__ void a_ready(const Unit&) const {}
    __device__ __forceinline__ void done(const Unit&) const {}
};
struct InOrderQ {
    int x, w;
    __device__ __forceinline__ bool next(int i, Unit& u) const {
        int f;
        if (w < 24) { if (i >= 3) return false; f = w + 24 * i; } else { if (i >= 1) return false; f = 72 + (w - 24); }
        u.pm = 8 * x + (f & 7); const int qt = f >> 3; u.pn = qt < 4 ? qt : qt + 1; return true;
    }
    __device__ __forceinline__ void a_ready(const Unit&) const {}
    __device__ __forceinline__ void done(const Unit&) const {}
};
struct UkvOrder {
    int x, p, cached;
    __device__ __forceinline__ bool next(int i, Unit& u) const {
        if (cached) { if (i >= 1) return false; u.pm = 32 + (x - 4) * 9; u.pn = p; return true; }
        const int pm = 8 * x + p;
        if (i < 8) { u.pm = pm < 32 ? pm : 32 + ((pm - 32) >> 3) * 9 + 1 + ((pm - 32) & 7); u.pn = i; return true; }
        return false;
    }
    __device__ __forceinline__ void a_ready(const Unit&) const {}
    __device__ __forceinline__ void done(const Unit&) const {}
};


template <class Epi, class Sched, bool ALIGN_EPI = false, bool SP2 = false, bool FP8 = false, int SCL_W = 0x7F7F7F7F, int SCL_A = 0x7F7F7F7F>
__device__ __forceinline__ void gemm_phase(PG8_LAS unsigned char* lds, const Gemm g, const Sched& S, const Epi& E) {
    int tid = threadIdx.x; asm volatile("" : "+v"(tid));
    const int wid = __builtin_amdgcn_readfirstlane(tid >> 6), lane = tid & 63, wr = wid >> 2, wc = wid & 3, fr = lane & 15, fq = lane >> 4;
    const int K = g.K, nt = FP8 ? K / (2 * BK) : K / BK;
    int sclw_ = SCL_W, scla_ = SCL_A; asm volatile("" : "+v"(sclw_), "+v"(scla_));
    unsigned voffA[2], voffB[2];
#pragma unroll
    for (int i = 0; i < 2; ++i) { int R, C; stage_rc(tid * 16 + i * 8192, R, C); const int Rb = Epi::PERM ? ((R & ~31) + perm32(R & 31)) : R;
        voffA[i] = FP8 ? (unsigned)(R * K + 2 * C) : (unsigned)(R * K + C) * 2u; voffB[i] = FP8 ? (unsigned)(Rb * K + 2 * C) : (unsigned)(Rb * K + C) * 2u; }
    const size_t kstep = (size_t)(BK * 2);
    const size_t hstep = (size_t)HALF * K * (FP8 ? 1 : 2);
    const size_t tstep = 2 * hstep;
    const unsigned ldsw = (unsigned)wid * 1024u;
    const int aoff = FP8 ? lds_byte(wr * 64 + fr, 16 * (fq & 1)) + (fq >> 1) * 1024 : lds_byte(wr * 64 + fr, fq * 8), boff = FP8 ? lds_byte(wc * 32 + fr, 16 * (fq & 1)) + (fq >> 1) * 1024 : lds_byte(wc * 32 + fr, fq * 8);
    constexpr int KST = FP8 ? 16 : 1024;
#define PG8_SA(b, h) (((b) * 2 + (h)) * HTB)
#define PG8_SB(b, h) ((4 + (b) * 2 + (h)) * HTB)
#define PG8_STAGE(bufoff, gbase, voff) do { _Pragma("unroll") for (int _i = 0; _i < 2; ++_i) \
        __builtin_amdgcn_global_load_lds((const unsigned*)((const char*)(gbase) + (voff)[_i]), (PG8_LAS unsigned*)(lds + (bufoff) + ldsw + _i * 8192), 16, 0, 0); } while (0)
#define PG8_LDA(dst, b, h) do { _Pragma("unroll") for (int m = 0; m < 4; ++m) _Pragma("unroll") for (int k = 0; k < 2; ++k) dst[m][k] = *(const PG8_LAS bf16x8*)(lds + PG8_SA(b, h) + aoff + m * 2048 + k * KST); } while (0)
#define PG8_LDB(dst, b, h) do { _Pragma("unroll") for (int n = 0; n < 2; ++n) _Pragma("unroll") for (int k = 0; k < 2; ++k) dst[n][k] = *(const PG8_LAS bf16x8*)(lds + PG8_SB(b, h) + boff + n * 2048 + k * KST); } while (0)
#define PG8_CAT(x) __builtin_shufflevector(__builtin_bit_cast(pg8_i32x4, (x)[0]), __builtin_bit_cast(pg8_i32x4, (x)[1]), 0, 1, 2, 3, 4, 5, 6, 7)
#define PG8_MMA(ai, bj, At, Bt) do { __builtin_amdgcn_s_setprio(1); \
        if constexpr (FP8) { _Pragma("unroll") for (int m = 0; m < 4; ++m) _Pragma("unroll") for (int n = 0; n < 2; ++n) \
            asm volatile("v_mfma_scale_f32_16x16x128_f8f6f4 %0, %1, %2, %0, %3, %4 op_sel_hi:[0,0,0]" : "+v"(acc[ai][bj][m][n]) : "v"(PG8_CAT(Bt[n])), "v"(PG8_CAT(At[m])), "v"(sclw_), "v"(scla_)); } \
        else { _Pragma("unroll") for (int m = 0; m < 4; ++m) _Pragma("unroll") for (int n = 0; n < 2; ++n) _Pragma("unroll") for (int k = 0; k < 2; ++k) \
            acc[ai][bj][m][n] = __builtin_amdgcn_mfma_f32_16x16x32_bf16(Bt[n][k], At[m][k], acc[ai][bj][m][n], 0, 0, 0); } \
        __builtin_amdgcn_s_setprio(0); } while (0)
#define PG8_WAIT_V(n) asm volatile("s_waitcnt vmcnt(" #n ")" ::: "memory")
#define PG8_WAIT_L(n) asm volatile("s_waitcnt lgkmcnt(" #n ")" ::: "memory")
#define PG8_BAR __builtin_amdgcn_s_barrier()
#define PG8_SCHED __builtin_amdgcn_sched_barrier(0)
    Unit cur, nxt; int ui = 0;
    if (!S.next(0, cur)) return;
    f32x4 acc[2][2][4][2];
#pragma unroll
    for (int a = 0; a < 2; ++a)
#pragma unroll
        for (int b = 0; b < 2; ++b)
#pragma unroll
            for (int m = 0; m < 4; ++m)
#pragma unroll
                for (int n = 0; n < 2; ++n) acc[a][b][m][n] = (f32x4){0.f, 0.f, 0.f, 0.f};
    bf16x8 At[4][2], B0[2][2], B1[2][2];
    const char* cA = (const char*)g.A + (size_t)cur.pm * tstep; const char* cB = (const char*)g.Bt + (size_t)cur.pn * tstep;
    S.a_ready(cur);
    if constexpr (SP2) {
        PG8_STAGE(PG8_SB(0, 0), cB, voffB); PG8_STAGE(PG8_SB(0, 1), cB + hstep, voffB); PG8_STAGE(PG8_SA(0, 0), cA, voffA); PG8_STAGE(PG8_SA(0, 1), cA + hstep, voffA);
        if (wr == 1) PG8_BAR;
        PG8_WAIT_V(2); PG8_BAR;
        PG8_STAGE(PG8_SB(1, 0), cB + kstep, voffB); PG8_STAGE(PG8_SA(1, 0), cA + kstep, voffA); PG8_STAGE(PG8_SB(1, 1), cB + hstep + kstep, voffB);
        PG8_WAIT_V(6); PG8_BAR;
    } else {
        PG8_STAGE(PG8_SB(0, 0), cB, voffB); PG8_STAGE(PG8_SA(0, 0), cA, voffA); PG8_STAGE(PG8_SB(0, 1), cB + hstep, voffB); PG8_STAGE(PG8_SA(0, 1), cA + hstep, voffA);
        if (wr == 1) PG8_BAR;
        PG8_WAIT_V(4); PG8_BAR;
        PG8_STAGE(PG8_SB(1, 0), cB + kstep, voffB); PG8_STAGE(PG8_SA(1, 0), cA + kstep, voffA); PG8_STAGE(PG8_SB(1, 1), cB + hstep + kstep, voffB);
        PG8_WAIT_V(6); PG8_BAR;
    }
    for (;;) {
        const bool has_next = S.next(ui + 1, nxt);
        const char* nA = has_next ? (const char*)g.A + (size_t)nxt.pm * tstep : cA; const char* nB = has_next ? (const char*)g.Bt + (size_t)nxt.pn * tstep : cB;
        for (int t = 0; t < nt; t += 2) {
            const bool last = (t == nt - 2);
            const char* a1 = cA + (size_t)(t + 1) * kstep;
            const char* a2 = last ? nA : cA + (size_t)(t + 2) * kstep; const char* b2 = last ? nB : cB + (size_t)(t + 2) * kstep;
            const char* a3 = a2 + kstep; const char* b3 = b2 + kstep;
            if (last && has_next) S.a_ready(nxt);
            if constexpr (SP2) {
            PG8_LDB(B0, 0, 0); PG8_LDB(B1, 0, 1); PG8_SCHED; PG8_LDA(At, 0, 0); PG8_STAGE(PG8_SA(1, 1), a1 + hstep, voffA);
            PG8_WAIT_V(8); PG8_WAIT_L(0); PG8_BAR; PG8_MMA(0, 0, At, B0); PG8_MMA(0, 1, At, B1); PG8_BAR; PG8_SCHED;
            PG8_LDA(At, 0, 1); PG8_STAGE(PG8_SB(0, 0), b2, voffB); PG8_STAGE(PG8_SB(0, 1), b2 + hstep, voffB); PG8_STAGE(PG8_SA(0, 0), a2, voffA);
            PG8_WAIT_V(8); PG8_WAIT_L(0); PG8_BAR; PG8_MMA(1, 0, At, B0); PG8_MMA(1, 1, At, B1); PG8_BAR; PG8_SCHED;
            PG8_LDB(B0, 1, 0); PG8_LDB(B1, 1, 1); PG8_SCHED; PG8_LDA(At, 1, 0); PG8_STAGE(PG8_SA(0, 1), a2 + hstep, voffA);
            PG8_WAIT_V(8); PG8_WAIT_L(0); PG8_BAR; PG8_MMA(0, 0, At, B0); PG8_MMA(0, 1, At, B1); PG8_BAR; PG8_SCHED;
            PG8_LDA(At, 1, 1); PG8_STAGE(PG8_SB(1, 0), b3, voffB); PG8_STAGE(PG8_SB(1, 1), b3 + hstep, voffB); PG8_STAGE(PG8_SA(1, 0), a3, voffA);
            PG8_WAIT_V(8); PG8_WAIT_L(0); PG8_BAR; PG8_MMA(1, 0, At, B0); PG8_MMA(1, 1, At, B1); PG8_BAR; PG8_SCHED;
            } else {
            PG8_LDB(B0, 0, 0); PG8_SCHED; PG8_LDA(At, 0, 0); PG8_STAGE(PG8_SA(1, 1), a1 + hstep, voffA);
            PG8_WAIT_L(8); PG8_BAR; PG8_WAIT_L(0); PG8_MMA(0, 0, At, B0); PG8_BAR; PG8_SCHED;
            PG8_LDB(B1, 0, 1); PG8_STAGE(PG8_SB(0, 0), b2, voffB);
            PG8_BAR; PG8_WAIT_L(0); PG8_MMA(0, 1, At, B1); PG8_BAR;
            PG8_LDA(At, 0, 1); PG8_STAGE(PG8_SA(0, 0), a2, voffA);
            PG8_BAR; PG8_WAIT_L(0); PG8_MMA(1, 0, At, B0); PG8_BAR; PG8_SCHED;
            PG8_STAGE(PG8_SB(0, 1), b2 + hstep, voffB);
            PG8_WAIT_V(6); PG8_BAR; PG8_MMA(1, 1, At, B1); PG8_BAR;
            PG8_LDB(B0, 1, 0); PG8_SCHED; PG8_LDA(At, 1, 0); PG8_STAGE(PG8_SA(0, 1), a2 + hstep, voffA);
            PG8_WAIT_L(8); PG8_BAR; PG8_WAIT_L(0); PG8_MMA(0, 0, At, B0); PG8_BAR; PG8_SCHED;
            PG8_LDB(B1, 1, 1); PG8_STAGE(PG8_SB(1, 0), b3, voffB);
            PG8_BAR; PG8_WAIT_L(0); PG8_MMA(0, 1, At, B1); PG8_BAR;
            PG8_LDA(At, 1, 1); PG8_STAGE(PG8_SA(1, 0), a3, voffA);
            PG8_BAR; PG8_WAIT_L(0); PG8_MMA(1, 0, At, B0); PG8_BAR; PG8_SCHED;
            PG8_STAGE(PG8_SB(1, 1), b3 + hstep, voffB);
            PG8_WAIT_V(6); PG8_BAR; PG8_MMA(1, 1, At, B1); PG8_BAR;
            }
        }
        if constexpr (ALIGN_EPI) { if (wr == 0) PG8_BAR; }
        if constexpr (!Epi::AFTER_DRAIN) { E(acc, cur, wr, wc, fr, fq); S.done(cur); }
        if (!has_next) break;
#pragma unroll
        for (int a = 0; a < 2; ++a)
#pragma unroll
            for (int b = 0; b < 2; ++b)
#pragma unroll
                for (int m = 0; m < 4; ++m)
#pragma unroll
                    for (int n = 0; n < 2; ++n) acc[a][b][m][n] = (f32x4){0.f, 0.f, 0.f, 0.f};
        cur = nxt; cA = nA; cB = nB; ++ui;
        if constexpr (ALIGN_EPI) { if (wr == 1) PG8_BAR; }
    }
    PG8_WAIT_V(0);
    if constexpr (!ALIGN_EPI) { if (wr == 0) PG8_BAR; }
    PG8_BAR;
    if constexpr (Epi::AFTER_DRAIN) { E.fused(acc, cur, wr, wc, fr, fq, lds, wid, lane); S.done(cur); }
#undef PG8_SA
#undef PG8_SB
#undef PG8_STAGE
#undef PG8_LDA
#undef PG8_LDB
#undef PG8_MMA
#undef PG8_CAT
#undef PG8_WAIT_V
#undef PG8_WAIT_L
#undef PG8_BAR
#undef PG8_SCHED
}
}


namespace att {
#define ALAS __attribute__((address_space(3)))
typedef unsigned short bf16_t;
using bf16x8 = __attribute__((ext_vector_type(8))) short;
using s16x4  = __attribute__((ext_vector_type(4))) short;
using f32x16 = __attribute__((ext_vector_type(16))) float;
using u32x4  = __attribute__((ext_vector_type(4))) unsigned;
using i32x4  = __attribute__((ext_vector_type(4))) int;
using i32x8  = __attribute__((ext_vector_type(8))) int;
using i32x2  = __attribute__((ext_vector_type(2))) int;
constexpr int KVBLK = 64, QBLK = 32;
constexpr int SHM_V = KVBLK * 128, SHM_K = KVBLK * 128, SHM_KR = KVBLK * 64;
constexpr int NBUF = 3;
constexpr int ATT_LDS_BYTES = NBUF * SHM_V + NBUF * SHM_K + 2048 + NBUF * SHM_KR;
constexpr float THR = 5.f;
#define KSWZ8(row, colB) ((row) * 128 + ((colB) ^ ((((row) >> 1) & 7) << 4)))
#define VSWZ8(row, c16) ((row) * 128 + (((((c16) >> 1) ^ (((row) >> 1) & 3)) << 5) | (((c16) & 1) << 4)))
#define KSWZ4(row, colB) ((row) * 64 + ((colB) ^ ((((row) >> 2) & 3) << 4)))
#define SBAR() __builtin_amdgcn_sched_barrier(0)
__device__ __forceinline__ int crow(int r, int hi) { return (r & 3) + 8 * (r >> 2) + 4 * hi; }
__device__ __forceinline__ unsigned cvtpk(float lo, float hi) { unsigned r; asm volatile("v_cvt_pk_bf16_f32 %0, %1, %2" : "=v"(r) : "v"(lo), "v"(hi)); return r; }

__device__ __forceinline__ void partialSM(f32x16& p0, f32x16& p1, float& m_reg, float& mn, float& alpha, const float C, const float thrs) {
  float pmax = p0[0];
#pragma unroll
  for (int r = 1; r < 16; ++r) pmax = fmaxf(pmax, p0[r]);
#pragma unroll
  for (int r = 0; r < 16; ++r) pmax = fmaxf(pmax, p1[r]);
  { auto rr = __builtin_amdgcn_permlane32_swap(__float_as_uint(pmax), __float_as_uint(pmax), false, false);
    pmax = fmaxf(__uint_as_float(rr[0]), __uint_as_float(rr[1])); }
  if (__builtin_expect(__all(pmax - m_reg <= thrs), 1)) { mn = m_reg; alpha = 1.f; }
  else { mn = fmaxf(m_reg, pmax); alpha = __builtin_amdgcn_exp2f((m_reg - mn) * C); m_reg = mn; }
  float mnC = -mn * C;
#pragma unroll
  for (int r = 0; r < 16; ++r) p0[r] = fmaf(p0[r], C, mnC);
#pragma unroll
  for (int r = 0; r < 16; ++r) p1[r] = fmaf(p1[r], C, mnC);
#pragma unroll
  for (int r = 0; r < 16; ++r) p0[r] = __builtin_amdgcn_exp2f(p0[r]);
}
__device__ __forceinline__ int cvt4_fp8(float a, float b, float c, float d) { int w = __builtin_amdgcn_cvt_pk_fp8_f32(a, b, 0, false); return __builtin_amdgcn_cvt_pk_fp8_f32(c, d, w, true); }
__device__ __forceinline__ void finishSM(f32x16& p0, f32x16& p1, float alpha, float& l_reg, i32x8& pa) {
#pragma unroll
  for (int r = 0; r < 16; ++r) p1[r] = __builtin_amdgcn_exp2f(p1[r]);
  float ps = 0;
#pragma unroll
  for (int r = 0; r < 16; ++r) ps += p0[r];
#pragma unroll
  for (int r = 0; r < 16; ++r) ps += p1[r];
  { auto rr = __builtin_amdgcn_permlane32_swap(__float_as_uint(ps), __float_as_uint(ps), false, false);
    ps = __uint_as_float(rr[0]) + __uint_as_float(rr[1]); }
  l_reg = l_reg * alpha + ps;
#pragma unroll
  for (int j = 0; j < 4; ++j) { const unsigned d = (unsigned)cvt4_fp8(p0[4 * j], p0[4 * j + 1], p0[4 * j + 2], p0[4 * j + 3]), e = (unsigned)cvt4_fp8(p1[4 * j], p1[4 * j + 1], p1[4 * j + 2], p1[4 * j + 3]);
    auto rr = __builtin_amdgcn_permlane32_swap(d, e, false, false); pa[2 * j] = (int)rr[0]; pa[2 * j + 1] = (int)rr[1]; }
}
template <bool MLA>
__device__ __forceinline__ void qkt(f32x16& p0, f32x16& p1, const ALAS char* Ks, const ALAS char* Krs, const i32x8* q8, int r32, int hi, int scl) {
  p0 = f32x16{}; p1 = f32x16{};
#define LD32(base, off0, off1) ({ const i32x4 l_ = *reinterpret_cast<const ALAS i32x4*>((base) + (off0)), h_ = *reinterpret_cast<const ALAS i32x4*>((base) + (off1)); (i32x8){l_[0], l_[1], l_[2], l_[3], h_[0], h_[1], h_[2], h_[3]}; })
#pragma unroll
  for (int ks = 0; ks < 2; ++ks) { const int cb = ks * 64 + hi * 32;
    const i32x8 a0 = LD32(Ks, KSWZ8(r32, cb), KSWZ8(r32, cb + 16)), a1 = LD32(Ks, KSWZ8(32 + r32, cb), KSWZ8(32 + r32, cb + 16));
    p0 = __builtin_amdgcn_mfma_scale_f32_32x32x64_f8f6f4(a0, q8[ks], p0, 0, 0, 0, scl, 0, scl);
    p1 = __builtin_amdgcn_mfma_scale_f32_32x32x64_f8f6f4(a1, q8[ks], p1, 0, 0, 0, scl, 0, scl); }
  if constexpr (MLA) { const int cb = hi * 32;
    const i32x8 a0 = LD32(Krs, KSWZ4(r32, cb), KSWZ4(r32, cb + 16)), a1 = LD32(Krs, KSWZ4(32 + r32, cb), KSWZ4(32 + r32, cb + 16));
    p0 = __builtin_amdgcn_mfma_scale_f32_32x32x64_f8f6f4(a0, q8[2], p0, 0, 0, 0, scl, 0, scl);
    p1 = __builtin_amdgcn_mfma_scale_f32_32x32x64_f8f6f4(a1, q8[2], p1, 0, 0, 0, scl, 0, scl); }
#undef LD32
}
template <int OFF> __device__ __forceinline__ i32x2 tr_read8(int vb) {
  i32x2 r; asm volatile("ds_read_b64_tr_b8 %0, %1 offset:%2" : "=&v"(r) : "v"(vb), "i"(OFF) : "memory"); return r;
}
__device__ __forceinline__ int v8_rd_base(int lane, int d0) { const int i16 = lane & 15, q = i16 >> 1, p = i16 & 1, g = (lane >> 4) & 1, hi = lane >> 5;
  return (32 * hi + q) * 128 + ((d0 ^ ((q >> 1) & 3)) << 5) + 16 * g + 8 * p; }
template <int BUF_OFF> __device__ __forceinline__ void pv_one(f32x16& od, int vb, const i32x8& pa, int scl) {
  const i32x2 t0 = tr_read8<BUF_OFF>(vb), t1 = tr_read8<BUF_OFF + 1024>(vb), t2 = tr_read8<BUF_OFF + 2048>(vb), t3 = tr_read8<BUF_OFF + 3072>(vb);
  asm volatile("s_waitcnt lgkmcnt(0)" ::: "memory"); SBAR();
  const i32x8 b = (i32x8){t0[0], t0[1], t1[0], t1[1], t2[0], t2[1], t3[0], t3[1]};
  od = __builtin_amdgcn_mfma_scale_f32_32x32x64_f8f6f4(pa, b, od, 0, 0, 0, scl, 0, scl);
}
template <int BUF_OFF> __device__ __forceinline__ void pv_d0(f32x16* o, const int (&vb)[4], const i32x8& pa, int scl) {
  pv_one<BUF_OFF>(o[0], vb[0], pa, scl); pv_one<BUF_OFF>(o[1], vb[1], pa, scl); pv_one<BUF_OFF>(o[2], vb[2], pa, scl); pv_one<BUF_OFF>(o[3], vb[3], pa, scl);
}

template <bool MLA, int LDK, int SDEPTH>
__device__ __forceinline__ void attn_unit(const unsigned char* __restrict__ Qn, const unsigned char* __restrict__ Qr, const unsigned char* __restrict__ Kn, const unsigned char* __restrict__ Kr,
                                          const unsigned char* __restrict__ Vh, bf16_t* __restrict__ Ob, int seq, ALAS char* lds) {
  constexpr int NQ = MLA ? 3 : 2, LDQN = 1024, LDQR = 512, LDO = 2048;
  constexpr float SCALE = MLA ? 0.07216878364870323f : 0.08838834764831845f;
  constexpr float C = SCALE * 1.4426950408889634f, THRS = THR / SCALE;
  int tid = threadIdx.x; asm volatile("" : "+v"(tid));
  const int wid = tid >> 6, lane = tid & 63, r32 = lane & 31, hi = lane >> 5;
  int scl = 0x7F7F7F7F; asm volatile("" : "+v"(scl));
  ALAS char* V_lds = lds; ALAS char* K_lds = lds + NBUF * SHM_V; ALAS char* KR_lds = lds + NBUF * SHM_V + NBUF * SHM_K + 2048;
  ALAS float* wsf = (ALAS float*)(lds + NBUF * SHM_V + NBUF * SHM_K) + wid * 64; ALAS float* li_l = wsf; ALAS float* al_l = wsf + 32;
  float m_reg = -1e30f, l_reg = 0; f32x16 o[4] = {}; i32x8 qr[NQ];
  { const unsigned char* Qw = Qn + (long)(wid * QBLK + r32) * LDQN + hi * 32;
#pragma unroll
    for (int ks = 0; ks < 2; ++ks) { const i32x4 l_ = *reinterpret_cast<const i32x4*>(Qw + ks * 64), h_ = *reinterpret_cast<const i32x4*>(Qw + ks * 64 + 16);
      qr[ks] = (i32x8){l_[0], l_[1], l_[2], l_[3], h_[0], h_[1], h_[2], h_[3]}; }
    if constexpr (MLA) { const unsigned char* Qw2 = Qr + (long)(wid * QBLK + r32) * LDQR + hi * 32;
      const i32x4 l_ = *reinterpret_cast<const i32x4*>(Qw2), h_ = *reinterpret_cast<const i32x4*>(Qw2 + 16);
      qr[2] = (i32x8){l_[0], l_[1], l_[2], l_[3], h_[0], h_[1], h_[2], h_[3]}; } }
  const int kr8 = tid >> 3, kc8 = (tid & 7) * 16;
  const int rr4 = (tid >> 2) & 63, rc4 = (tid & 3) * 16; const bool rope_thr = tid < 256;
  const int vl = (int)(uintptr_t)V_lds; const int vb0[4] = {vl + v8_rd_base(lane, 0), vl + v8_rd_base(lane, 1), vl + v8_rd_base(lane, 2), vl + v8_rd_base(lane, 3)};
  struct { i32x4 vs, ks, kr; } sr_[SDEPTH];
#define SLOAD(i, k0) do { sr_[i].vs = *reinterpret_cast<const i32x4*>(&Vh[(long)((k0) + kr8) * LDK + kc8]); sr_[i].ks = *reinterpret_cast<const i32x4*>(&Kn[(long)((k0) + kr8) * LDK + kc8]); \
    if constexpr (MLA) { if (rope_thr) sr_[i].kr = *reinterpret_cast<const i32x4*>(&Kr[(long)((k0) + rr4) * 64 + rc4]); } } while (0)
#define SWRITE(b, i) do { *(ALAS i32x4*)(V_lds + (b) * SHM_V + VSWZ8(kr8, (tid & 7))) = sr_[i].vs; *(ALAS i32x4*)(K_lds + (b) * SHM_K + KSWZ8(kr8, kc8)) = sr_[i].ks; \
    if constexpr (MLA) { if (rope_thr) *(ALAS i32x4*)(KR_lds + (b) * SHM_KR + KSWZ4(rr4, rc4)) = sr_[i].kr; } } while (0)
#define SWAIT() do { if constexpr (SDEPTH == 1) asm volatile("s_waitcnt vmcnt(0)" ::: "memory"); else asm volatile("s_waitcnt vmcnt(2)" ::: "memory"); } while (0)
#define RESC(a) do { if (__any((a) < 1.f)) { if (hi == 0) al_l[r32] = (a); asm volatile("s_waitcnt lgkmcnt(0)" ::: "memory"); \
    _Pragma("unroll") for (int d = 0; d < 4; ++d) _Pragma("unroll") for (int r = 0; r < 16; ++r) o[d][r] *= al_l[crow(r, hi)]; } } while (0)
  f32x16 pA0, pA1, pB0, pB1; float mnA, mnB, alA, alB; i32x8 pa; const int NT = seq / KVBLK;
  constexpr int SE = 0, SO = SDEPTH - 1;
  SLOAD(SE, 0); asm volatile("s_waitcnt vmcnt(0)" ::: "memory"); SWRITE(0, SE); __syncthreads();
  qkt<MLA>(pA0, pA1, K_lds, KR_lds, qr, r32, hi, scl); partialSM(pA0, pA1, m_reg, mnA, alA, C, THRS);
  SLOAD(SO, KVBLK); if constexpr (SDEPTH == 2) { if (2 < NT) SLOAD(SE, 2 * KVBLK); }
  SWAIT(); SWRITE(1, SO); __syncthreads();
  int kb = 1;
#define VBX(b) const int vbx[4] = {vb0[0] + (b) * SHM_V, vb0[1] + (b) * SHM_V, vb0[2] + (b) * SHM_V, vb0[3] + (b) * SHM_V}
  for (int j = 1; j + 1 < NT; j += 2) {
    { const int vbi = kb == 0 ? 2 : kb - 1, wbi = kb == 2 ? 0 : kb + 1; VBX(vbi);
      SBAR(); qkt<MLA>(pB0, pB1, K_lds + kb * SHM_K, KR_lds + kb * SHM_KR, qr, r32, hi, scl);
      finishSM(pA0, pA1, alA, l_reg, pa); SBAR();
      SLOAD(SO, (j + SDEPTH) * KVBLK); SBAR();
      pv_d0<0>(o, vbx, pa, scl); partialSM(pB0, pB1, m_reg, mnB, alB, C, THRS);
      SWAIT(); SWRITE(wbi, SE);
      RESC(alB); __syncthreads(); kb = wbi; }
    { const int vbi = kb == 0 ? 2 : kb - 1, wbi = kb == 2 ? 0 : kb + 1; VBX(vbi);
      SBAR(); qkt<MLA>(pA0, pA1, K_lds + kb * SHM_K, KR_lds + kb * SHM_KR, qr, r32, hi, scl);
      finishSM(pB0, pB1, alB, l_reg, pa); SBAR();
      if (SDEPTH == 1 || j + 3 < NT) SLOAD(SE, (j + 1 + SDEPTH) * KVBLK); SBAR();
      pv_d0<0>(o, vbx, pa, scl); partialSM(pA0, pA1, m_reg, mnA, alA, C, THRS);
      SWAIT(); SWRITE(wbi, SO);
      RESC(alA); __syncthreads(); kb = wbi; }
  }
  { const int vbi = kb == 0 ? 2 : kb - 1; VBX(vbi);
    SBAR(); qkt<MLA>(pB0, pB1, K_lds + kb * SHM_K, KR_lds + kb * SHM_KR, qr, r32, hi, scl);
    finishSM(pA0, pA1, alA, l_reg, pa); SBAR();
    pv_d0<0>(o, vbx, pa, scl); partialSM(pB0, pB1, m_reg, mnB, alB, C, THRS); }
  __syncthreads(); RESC(alB);
  finishSM(pB0, pB1, alB, l_reg, pa); SBAR();
  { VBX(kb); pv_d0<0>(o, vbx, pa, scl); }
#undef VBX
  if (hi == 0) li_l[r32] = l_reg; asm volatile("s_waitcnt lgkmcnt(0)" ::: "memory");
  float rli[16];
#pragma unroll
  for (int r = 0; r < 16; ++r) rli[r] = __builtin_amdgcn_rcpf(li_l[crow(r, hi)]);
  bf16_t* Ow = Ob + (long)(wid * QBLK) * LDO;
#pragma unroll
  for (int r = 0; r < 16; r += 2) {
#pragma unroll
    for (int d0 = 0; d0 < 4; ++d0) {
      const float a = o[d0][r] * rli[r], b = o[d0][r + 1] * rli[r + 1];
      const float send = (lane & 1) ? a : b;
      const float recv = __uint_as_float((unsigned)__builtin_amdgcn_mov_dpp((int)__float_as_uint(send), 0xB1, 0xF, 0xF, true));
      const unsigned w = (lane & 1) ? cvtpk(recv, b) : cvtpk(a, recv);
      const int orow = crow(r + (lane & 1), hi);
      *reinterpret_cast<unsigned*>(Ow + (long)orow * LDO + d0 * 32 + (r32 & ~1)) = w;
    }
  }
  __syncthreads();
#undef SLOAD
#undef SWRITE
#undef SWAIT
#undef RESC
}
}


constexpr int NWAVES = 8;
constexpr int DM = 2048, NCTX = 8192, NLAT = 8192, MTOK = NCTX + NLAT, DEPTH = 4, NGRP = 5;
constexpr int IN_COLS = 3392, INP = 3584, DFF = 5632, NGU = 2 * DFF, KROWS = NCTX + 4 * 2304, MODW = 6 * DM;
constexpr int KCH = 32;
constexpr size_t OUT_Y = 0, OUT_KA = 33554432, OUT_VA = 41943040, OUT_CKV = 50331648, OUT_KR = 58720256, OUT_TOTAL = 60817408;
constexpr size_t MiB = 1u << 20;
constexpr size_t WS_CTL = 0, CTL_ZERO_BYTES = 1 * MiB;
constexpr size_t WS_MOD = 1 * MiB;
constexpr size_t WS_PART = 2 * MiB;
constexpr size_t WS_WIN = 32 * MiB, SZ_WIN = 14 * MiB;
constexpr size_t WS_WO = 88 * MiB, SZ_WO = 8 * MiB;
constexpr size_t WS_WGU = 120 * MiB, SZ_WGU = 44 * MiB;
constexpr size_t WS_WD = 296 * MiB, SZ_WD = 22 * MiB;
constexpr size_t WS_WUKV = 384 * MiB, SZ_WUKV = 1 * MiB;
constexpr size_t WS_X = 388 * MiB;
constexpr size_t WS_XN = 516 * MiB;
constexpr size_t WS_H = 580 * MiB;
constexpr size_t WS_QA = 756 * MiB, WS_QBN = 788 * MiB, WS_QBR = 820 * MiB, WS_O = 836 * MiB;
constexpr size_t WS_KA = 900 * MiB, SZ_KA = 9 * MiB, WS_VA = 936 * MiB, WS_CKV = 972 * MiB;
constexpr size_t WS_KR = 1008 * MiB, SZ_KR = 3 * MiB;
constexpr size_t WS_KBN = 1020 * MiB, WS_VB = 1054 * MiB;
constexpr size_t WS_WIN8 = 1088 * MiB, SZ_WIN8 = 7 * MiB;
constexpr size_t WS_XN8 = 1116 * MiB, WS_END = 1148 * MiB;
static_assert((size_t)KROWS * 256 * 2 <= SZ_KA && (size_t)KROWS * 64 * 2 <= SZ_KR && (size_t)KROWS * 1024 * 2 <= WS_VB - WS_KBN && (size_t)KCH * 4 * 5 * 12288 * 4 <= WS_WIN - WS_PART, "ws map");
constexpr int CW_BAR = 4096;
constexpr int RING_OFF = 0, RING_BYTES = 131072;
constexpr int XS_OFF = RING_BYTES;
constexpr int MISC_OFF = XS_OFF + 8192;
constexpr int PT_OFF = MISC_OFF + 256;
constexpr int LDS_BYTES = 147456;
static_assert(MISC_OFF + 128 <= LDS_BYTES && att::ATT_LDS_BYTES <= RING_BYTES, "LDS map");

#define GAS __attribute__((address_space(1)))
#define LAS __attribute__((address_space(3)))
typedef unsigned short bf16;
typedef unsigned v4u __attribute__((ext_vector_type(4)));
typedef unsigned v2u __attribute__((ext_vector_type(2)));
typedef float f32x4 __attribute__((ext_vector_type(4)));
#define LDS_WAIT() asm volatile("s_waitcnt lgkmcnt(0)" ::: "memory")
__device__ __forceinline__ unsigned pk2(float lo, float hi) { return pg8::cvt_pk_bf16(lo, hi); }
__device__ __forceinline__ float shx(float v, int lane, int m) { return __int_as_float(__builtin_amdgcn_ds_bpermute((lane ^ m) << 2, __float_as_int(v))); }
__device__ __forceinline__ float wave_sum(float v, int lane) {
#pragma unroll
    for (int o = 1; o < 64; o <<= 1) v += shx(v, lane, o);
    return v;
}
__device__ __forceinline__ float silu_f(float x) { return x / (1.0f + __expf(-x)); }

#define XB_TMO      128
#define XB_XCNT(j)  (256  + 64 * (j))
#define XB_XSUB(j)  (1280 + 64 * (j))
#define XB_XGEN(j)  (2304 + 64 * (j))
#define XB_TOP      3328
#define XB_TOPGEN   3392
#define XCD_BAR_WORDS 3456
#define XB_SPIN_CAP (1u << 18)

__device__ __forceinline__ unsigned xb_ld(unsigned* p)              { return __hip_atomic_load(p, __ATOMIC_RELAXED, __HIP_MEMORY_SCOPE_AGENT); }
__device__ __forceinline__ unsigned xb_add(unsigned* p, unsigned v) { return __hip_atomic_fetch_add(p, v, __ATOMIC_RELAXED, __HIP_MEMORY_SCOPE_AGENT); }
__device__ __forceinline__ unsigned xb_xcc_id() { return (unsigned)__builtin_amdgcn_s_getreg((3 << 11) | 20) & 0xFu; }
#define XB_SPIN(cond, bar) do { unsigned _sp = 0; while (cond) { __builtin_amdgcn_s_sleep(1); \
    if ((++_sp & 255u) == 0u) { if (xb_ld(&(bar)[XB_TMO])) break; if (_sp > XB_SPIN_CAP) { atomicAdd(&(bar)[XB_TMO], 1u); break; } } } } while (0)

__device__ __forceinline__ int xb_tid() { int t = threadIdx.x; asm volatile("" : "+v"(t)); return t; }
struct XcdBarrier {
    unsigned* bar; unsigned x;
    volatile LAS unsigned* st;
};

__device__ __forceinline__ XcdBarrier xcd_barrier_post(unsigned* bar, volatile LAS unsigned* st) {
    XcdBarrier b; b.bar = bar; b.x = xb_xcc_id(); b.st = st;
    if (xb_tid() == 0) (void)xb_add(&bar[XB_XCNT(b.x)], 1u);
    return b;
}
__device__ __forceinline__ void xcd_barrier_complete(unsigned* bar, unsigned x, unsigned& nloc, unsigned& nx) {
    const unsigned G = gridDim.x * gridDim.y * gridDim.z;
    unsigned sum, cnt, mine, sp = 0u;
    for (;;) {
        sum = 0u; cnt = 0u; mine = 0u;
#pragma unroll
        for (unsigned j = 0; j < 16; ++j) { const unsigned c = xb_ld(&bar[XB_XCNT(j)]); sum += c; cnt += (c > 0u) ? 1u : 0u; mine = (j == x) ? c : mine; }
        if (sum == G) break;
        __builtin_amdgcn_s_sleep(1);
        if ((++sp & 255u) == 0u) { if (xb_ld(&bar[XB_TMO])) break; if (sp > XB_SPIN_CAP) { atomicAdd(&bar[XB_TMO], 1u); break; } }
    }
    nloc = mine > 0u ? mine : 1u; nx = cnt > 0u ? cnt : 1u;
}

__device__ __forceinline__ void xcd_barrier(const XcdBarrier& b) {
    asm volatile("s_waitcnt vmcnt(0)" ::: "memory");
    __syncthreads();
    if (xb_tid() == 0) {
        unsigned* bar = b.bar;
        __builtin_amdgcn_s_waitcnt(0);
        unsigned nloc = b.st[0], nx = b.st[1];
        if (nloc == 0u) { xcd_barrier_complete(bar, b.x, nloc, nx); b.st[0] = nloc; b.st[1] = nx; }
        const unsigned old = xb_add(&bar[XB_XSUB(b.x)], 1u);
        const unsigned gen = old / nloc;
        if (old + 1u == (gen + 1u) * nloc) {
            __builtin_amdgcn_fence(__ATOMIC_RELEASE, "agent");
            asm volatile("s_waitcnt vmcnt(0)" ::: "memory");
            const unsigned og = xb_add(&bar[XB_TOP], 1u);
            const unsigned tg = og / nx;
            if (og + 1u == (tg + 1u) * nx) xb_add(&bar[XB_TOPGEN], 1u);
            else XB_SPIN(xb_ld(&bar[XB_TOPGEN]) == tg, bar);
            __builtin_amdgcn_fence(__ATOMIC_ACQUIRE, "agent");
            xb_add(&bar[XB_XGEN(b.x)], 1u);
            asm volatile("s_waitcnt vmcnt(0)" ::: "memory");
        } else {
            XB_SPIN(xb_ld(&bar[XB_XGEN(b.x)]) == gen, bar);
            __builtin_amdgcn_fence(__ATOMIC_ACQUIRE, "agent");
            asm volatile("s_waitcnt vmcnt(0)" ::: "memory");
        }
    }
    __syncthreads();
}


struct Args { const float* in[23]; float* out; unsigned char* ws; int ph_lo, ph_hi; };
enum { I_XP = 0, I_XS, I_CKA, I_CVA, I_CCKV, I_CKR, I_C, I_CCTX, I_WADA, I_BADA, I_NATT, I_NFFN, I_WIN, I_QN, I_KN, I_KVN, I_WUK, I_WUV, I_WO, I_WG, I_WU, I_WD, I_NF };
struct Frame {
    LAS unsigned char* lds;
    int wave, vcu, G;
    GAS unsigned char* ws;
};
template <int I> __device__ __forceinline__ const float* pin_() {
    const unsigned long long kp = (unsigned long long)__builtin_amdgcn_kernarg_segment_ptr();
    unsigned long long v;
    asm volatile("s_load_dwordx2 %0, %1, %2\n\ts_waitcnt lgkmcnt(0)" : "=s"(v) : "s"(kp), "i"(I * 8));
    return (const float*)(const GAS float*)v;
}
#define pin(F, I) pin_<(I)>()
__device__ __forceinline__ Frame fresh(const Frame& F) {
    Frame P = F;
    asm volatile("" : "+s"(P.ws), "+s"(P.lds), "+s"(P.vcu), "+s"(P.wave), "+s"(P.G));
    return P;
}
__device__ __forceinline__ int opaque_tid() { int t = threadIdx.x; asm volatile("" : "+v"(t)); return t; }


namespace pg8 {
__device__ __forceinline__ u32x2 pk8_fp8(float a0, float a1, float a2, float a3, float a4, float a5, float a6, float a7) {
    int lo = __builtin_amdgcn_cvt_pk_fp8_f32(a0, a1, 0, false); lo = __builtin_amdgcn_cvt_pk_fp8_f32(a2, a3, lo, true);
    int hi = __builtin_amdgcn_cvt_pk_fp8_f32(a4, a5, 0, false); hi = __builtin_amdgcn_cvt_pk_fp8_f32(a6, a7, hi, true);
    return (u32x2){(unsigned)lo, (unsigned)hi};
}
struct EpiIn {
    static constexpr bool PERM = true, AFTER_DRAIN = false;
    LAS unsigned char* lds; GAS unsigned char* ws; int l, pn_base;
    __device__ __forceinline__ void operator()(const f32x4 (&acc)[2][2][4][2], const Unit& u, int wr, int wc, int fr, int fq) const {
        { int t_ = threadIdx.x; asm volatile("" : "+v"(t_)); fr = t_ & 15; fq = (t_ >> 4) & 3; }
        const int pn = u.pn + pn_base, pm = u.pm;
        PG8_LAS float* xs = (PG8_LAS float*)(lds + XS_OFF);
        float* const outp = (float*)pin(F, 23);
        const bool lat = pm >= 32;
        const int lb = lat ? ((pm - 32) >> 3) : 0;
        const int kadd = lat ? 256 * (lb + 1) : 0;
        const int rbase = pm * BM + wr * 64 + fr;
        const int tb = lat ? (((pm - 32) & 7) * 256 + wr * 64) : (wr * 64);
        const float EPS = 1e-6f;
        float rstd[2][4][2];
        if (pn <= 4 || pn == 11) {
#pragma unroll
            for (int ai = 0; ai < 2; ++ai)
#pragma unroll
                for (int m = 0; m < 4; ++m)
#pragma unroll
                    for (int bj = 0; bj < 2; ++bj) { const f32x4 a = acc[ai][bj][m][0], b = acc[ai][bj][m][1];
                        float s = (a[0] * a[0] + a[1] * a[1]) + (a[2] * a[2] + a[3] * a[3]) + (b[0] * b[0] + b[1] * b[1]) + (b[2] * b[2] + b[3] * b[3]);
                        s += shx(s, fr + 16 * fq, 16); s += shx(s, fr + 16 * fq, 32);
                        if (fq == 0) xs[(ai * HALF + wr * 64 + m * 16 + fr) * 8 + bj * 4 + wc] = s; }
            asm volatile("s_waitcnt lgkmcnt(0)" ::: "memory"); __builtin_amdgcn_s_barrier(); asm volatile("" ::: "memory");
#pragma unroll
            for (int ai = 0; ai < 2; ++ai)
#pragma unroll
                for (int m = 0; m < 4; ++m) { const PG8_LAS f32x4* p = (const PG8_LAS f32x4*)(xs + (ai * HALF + wr * 64 + m * 16 + fr) * 8);
                    const f32x4 a = p[0], b = p[1]; const float s0 = (a[0] + a[1]) + (a[2] + a[3]), s1 = (b[0] + b[1]) + (b[2] + b[3]);
                    if (pn == 11) { const float r = __builtin_amdgcn_rsqf((s0 + s1) * (1.0f / 256.0f) + EPS); rstd[ai][m][0] = r; rstd[ai][m][1] = r; }
                    else { rstd[ai][m][0] = __builtin_amdgcn_rsqf(s0 * (1.0f / 128.0f) + EPS); rstd[ai][m][1] = __builtin_amdgcn_rsqf(s1 * (1.0f / 128.0f) + EPS); } }
        }
        const int p0 = 32 * wc + 8 * fq;
        if (pn <= 4) {
            const float* nw = ((pn == 4) ? pin(F, I_KN) : pin(F, I_QN)) + l * 128;
            float w[2][4], invf[2][2];
#pragma unroll
            for (int n = 0; n < 2; ++n)
#pragma unroll
                for (int e = 0; e < 4; ++e) { const int p = p0 + 4 * n + e; w[n][e] = nw[(p >> 1) + 64 * (p & 1)]; }
#pragma unroll
            for (int n = 0; n < 2; ++n)
#pragma unroll
                for (int eh = 0; eh < 2; ++eh) { const int f = (16 * wc + 4 * fq + 2 * n + eh) & 31; invf[n][eh] = __builtin_amdgcn_exp2f((float)f * (-13.287712379549449f / 32.0f)) * 0.15915494309189535f; }
#pragma unroll
            for (int ai = 0; ai < 2; ++ai)
#pragma unroll
                for (int m = 0; m < 4; ++m) {
                    const int r = rbase + ai * HALF + m * 16, t = tb + ai * HALF + m * 16 + fr;
                    const float pos = (float)((wc < 2) ? (t >> 6) : (t & 63));
#pragma unroll
                    for (int bj = 0; bj < 2; ++bj) {
                        float v[2][4]; const float rs = rstd[ai][m][bj];
#pragma unroll
                        for (int n = 0; n < 2; ++n)
#pragma unroll
                            for (int e = 0; e < 4; ++e) v[n][e] = acc[ai][bj][m][n][e] * rs * w[n][e];
                        if (lat) {
#pragma unroll
                            for (int n = 0; n < 2; ++n)
#pragma unroll
                                for (int eh = 0; eh < 2; ++eh) { const float rev = pos * invf[n][eh]; const float c = __builtin_amdgcn_cosf(rev), s = __builtin_amdgcn_sinf(rev);
                                    const float x1 = v[n][2 * eh], x2 = v[n][2 * eh + 1]; v[n][2 * eh] = x1 * c - x2 * s; v[n][2 * eh + 1] = x2 * c + x1 * s; }
                        } else if (pn == 4) {
                            float* o = outp + OUT_KA + (size_t)((pm * 4 + l) * 256 + t) * 256 + bj * HALF + 16 * wc + 4 * fq;
                            *(f32x4*)o = (f32x4){v[0][0], v[0][2], v[1][0], v[1][2]}; *(f32x4*)(o + 64) = (f32x4){v[0][1], v[0][3], v[1][1], v[1][3]};
                        }
                        const u32x2 pk = pk8_fp8(v[0][0], v[0][1], v[0][2], v[0][3], v[1][0], v[1][1], v[1][2], v[1][3]);
                        if (pn == 4) *(u32x2*)((GAS unsigned char*)(ws + WS_KA + (size_t)l * SZ_KA) + (size_t)(r + kadd) * 256 + bj * HALF + p0) = pk;
                        else *(u32x2*)((GAS unsigned char*)(ws + WS_QA) + (size_t)r * 1024 + (2 * pn + bj) * HALF + p0) = pk;
                    }
                }
        } else if (pn == 12 || (pn >= 5 && pn <= 8)) {
#pragma unroll
            for (int ai = 0; ai < 2; ++ai)
#pragma unroll
                for (int m = 0; m < 4; ++m) {
                    const int r = rbase + ai * HALF + m * 16, t = tb + ai * HALF + m * 16 + fr;
#pragma unroll
                    for (int bj = 0; bj < 2; ++bj) { const f32x4 v0 = acc[ai][bj][m][0], v1 = acc[ai][bj][m][1];
                        if (pn == 12) { *(u32x2*)((GAS unsigned char*)(ws + WS_VA + (size_t)l * SZ_KA) + (size_t)(r + kadd) * 256 + bj * HALF + p0) = pk8_fp8(v0[0], v0[1], v0[2], v0[3], v1[0], v1[1], v1[2], v1[3]);
                            if (!lat) { float* o = outp + OUT_VA + (size_t)((pm * 4 + l) * 256 + t) * 256 + bj * HALF + p0; *(f32x4*)o = v0; *(f32x4*)(o + 4) = v1; } }
                        else *(u32x2*)((GAS unsigned char*)(ws + WS_QBN) + (size_t)r * 1024 + (pn - 5) * 256 + bj * HALF + p0) = pk8_fp8(v0[0], v0[1], v0[2], v0[3], v1[0], v1[1], v1[2], v1[3]); }
                }
        } else if (pn == 9 || pn == 10 || pn == 13) {
            float invf[2][2];
#pragma unroll
            for (int n = 0; n < 2; ++n)
#pragma unroll
                for (int eh = 0; eh < 2; ++eh) { const int f = (4 * fq + 2 * n + eh) & 15; invf[n][eh] = __builtin_amdgcn_exp2f((float)f * (-13.287712379549449f / 16.0f)) * 0.15915494309189535f; }
#pragma unroll
            for (int ai = 0; ai < 2; ++ai)
#pragma unroll
                for (int m = 0; m < 4; ++m) {
                    const int r = rbase + ai * HALF + m * 16, t = tb + ai * HALF + m * 16 + fr;
                    const float pos = (float)(((wc & 1) == 0) ? (t >> 6) : (t & 63));
#pragma unroll
                    for (int bj = 0; bj < 2; ++bj) {
                        if (pn == 13 && (bj == 1 || wc >= 2)) continue;
                        float v[2][4];
#pragma unroll
                        for (int n = 0; n < 2; ++n)
#pragma unroll
                            for (int e = 0; e < 4; ++e) v[n][e] = acc[ai][bj][m][n][e];
                        if (lat) {
#pragma unroll
                            for (int n = 0; n < 2; ++n)
#pragma unroll
                                for (int eh = 0; eh < 2; ++eh) { const float rev = pos * invf[n][eh]; const float c = __builtin_amdgcn_cosf(rev), s = __builtin_amdgcn_sinf(rev);
                                    const float x1 = v[n][2 * eh], x2 = v[n][2 * eh + 1]; v[n][2 * eh] = x1 * c - x2 * s; v[n][2 * eh + 1] = x2 * c + x1 * s; }
                        } else if (pn == 13) {
                            float* o = outp + OUT_KR + (size_t)((pm * 4 + l) * 256 + t) * 64 + 16 * wc + 4 * fq;
                            *(f32x4*)o = (f32x4){v[0][0], v[0][2], v[1][0], v[1][2]}; *(f32x4*)(o + 32) = (f32x4){v[0][1], v[0][3], v[1][1], v[1][3]};
                        }
                        const u32x2 pk = pk8_fp8(v[0][0], v[0][1], v[0][2], v[0][3], v[1][0], v[1][1], v[1][2], v[1][3]);
                        if (pn == 13) *(u32x2*)((GAS unsigned char*)(ws + WS_KR + (size_t)l * SZ_KR) + (size_t)(r + kadd) * 64 + p0) = pk;
                        else *(u32x2*)((GAS unsigned char*)(ws + WS_QBR) + (size_t)r * 512 + (pn - 9) * 256 + bj * HALF + p0) = pk;
                    }
                }
        } else {
            f32x4 w[2][2];
#pragma unroll
            for (int bj = 0; bj < 2; ++bj)
#pragma unroll
                for (int n = 0; n < 2; ++n) w[bj][n] = *(const f32x4*)(pin(F, I_KVN) + l * 256 + bj * HALF + p0 + 4 * n);
#pragma unroll
            for (int ai = 0; ai < 2; ++ai)
#pragma unroll
                for (int m = 0; m < 4; ++m) {
                    const int r = rbase + ai * HALF + m * 16, t = tb + ai * HALF + m * 16 + fr;
#pragma unroll
                    for (int bj = 0; bj < 2; ++bj) { const float rs = rstd[ai][m][bj]; const f32x4 v0 = acc[ai][bj][m][0] * rs * w[bj][0], v1 = acc[ai][bj][m][1] * rs * w[bj][1];
                        u32x4 pk; pk.x = cvt_pk_bf16(v0[0], v0[1]); pk.y = cvt_pk_bf16(v0[2], v0[3]); pk.z = cvt_pk_bf16(v1[0], v1[1]); pk.w = cvt_pk_bf16(v1[2], v1[3]);
                        *(u32x4*)((bf16_t*)(ws + WS_CKV + (size_t)l * SZ_KA) + (size_t)(r + kadd) * 256 + bj * HALF + p0) = pk;
                        if (!lat) { float* o = outp + OUT_CKV + (size_t)((pm * 4 + l) * 256 + t) * 256 + bj * HALF + p0; *(f32x4*)o = v0; *(f32x4*)(o + 4) = v1; } }
                }
        }
    }
};
}

__device__ __forceinline__ int win_dest(int o) {
    if (o < 1280) { const int d = o & 127; return (o & ~127) + ((d < 64) ? 2 * d : 2 * (d - 64) + 1); }
    if (o < 1536) return 3072 + (o - 1280);
    if (o < 3072) { const int h = (o - 1536) / 192, j = (o - 1536) % 192;
        if (j < 128) return 1280 + h * 128 + j;
        const int i = j - 128; return 2304 + h * 64 + ((i < 32) ? 2 * i : 2 * (i - 32) + 1); }
    if (o < 3328) return 2816 + (o - 3072);
    { const int i = o - 3328; return 3328 + ((i < 32) ? 2 * i : 2 * (i - 32) + 1); }
}
template <int KIND> __device__ __forceinline__ int dest_row(int n, int row_off) {
    if (KIND == 1) return win_dest(n);
    if (KIND == 2) return ((n >> 7) << 8) + (n & 127);
    if (KIND == 3) return ((n >> 7) << 8) + 128 + (n & 127);
    return n + row_off;
}
template <int KIND>
__device__ __forceinline__ void p0_transpose_item(const float* W, int K, int N, bf16* WT, int row_off, LAS float* scr, int item, int lane) {
    const int nblk = N / 64, kb = item / nblk, nb = item % nblk, k0 = 64 * kb, n0 = 64 * nb;
    const int lr = lane >> 4, lc = (lane & 15) * 4;
    f32x4 v[16];
#pragma unroll
    for (int i = 0; i < 16; ++i) v[i] = *(const GAS f32x4*)(W + (size_t)(k0 + 4 * i + lr) * N + n0 + lc);
#pragma unroll
    for (int i = 0; i < 16; ++i) { LAS float* d = scr + (4 * i + lr) * 65 + lc; d[0] = v[i][0]; d[1] = v[i][1]; d[2] = v[i][2]; d[3] = v[i][3]; }
    LDS_WAIT(); asm volatile("" ::: "memory");
    const int c = lane & 7;
#pragma unroll
    for (int j = 0; j < 8; ++j) { const int n = (lane >> 3) + 8 * j; const LAS float* s = scr + (8 * c) * 65 + n;
        v4u o; o.x = pk2(s[0 * 65], s[1 * 65]); o.y = pk2(s[2 * 65], s[3 * 65]); o.z = pk2(s[4 * 65], s[5 * 65]); o.w = pk2(s[6 * 65], s[7 * 65]);
        *(GAS v4u*)(WT + (size_t)dest_row<KIND>(n0 + n, row_off) * K + k0 + 8 * c) = o; }
    LDS_WAIT(); asm volatile("" ::: "memory");
}

__device__ __forceinline__ void p0_prologue(const Frame F) {
    const int tid = opaque_tid(), lane = tid & 63;
    const int gw = F.vcu * NWAVES + F.wave, NGW = F.G * NWAVES;
    const int gt = F.vcu * (NWAVES * 64) + tid, NGT = F.G * NWAVES * 64;
    LAS float* sl = (LAS float*)(F.lds);
    for (int i = tid; i < NGRP * DM; i += NWAVES * 64) { const int g = i / DM, k = i % DM; const float v = (g == 0) ? pin(F, I_CCTX)[k] : pin(F, I_C)[(g - 1) * DM + k]; sl[i] = silu_f(v); }
    __syncthreads();
    {
        float* part = (float*)(F.ws + WS_PART);
        for (int task = gw; task < DEPTH * 48 * KCH; task += NGW) {
            const int kc = task % KCH, cg = (task / KCH) % 48, l = task / (KCH * 48);
            const float* wp = pin(F, I_WADA) + ((size_t)l * DM + (size_t)kc * 64) * MODW + cg * 256 + lane * 4;
            f32x4 acc[NGRP];
#pragma unroll
            for (int g = 0; g < NGRP; ++g) acc[g] = (f32x4){0.f, 0.f, 0.f, 0.f};
            for (int k16 = 0; k16 < 64; k16 += 16) {
                f32x4 w[16];
#pragma unroll
                for (int q = 0; q < 16; ++q) w[q] = __builtin_nontemporal_load((const GAS f32x4*)(wp + (size_t)(k16 + q) * MODW));
#pragma unroll
                for (int q4 = 0; q4 < 16; q4 += 4)
#pragma unroll
                    for (int g = 0; g < NGRP; ++g) { const f32x4 s = *(const LAS f32x4*)(sl + g * DM + kc * 64 + k16 + q4);
                        acc[g] += w[q4 + 0] * s[0]; acc[g] += w[q4 + 1] * s[1]; acc[g] += w[q4 + 2] * s[2]; acc[g] += w[q4 + 3] * s[3]; }
            }
#pragma unroll
            for (int g = 0; g < NGRP; ++g) *(f32x4*)(part + (((size_t)kc * DEPTH + l) * NGRP + g) * MODW + cg * 256 + lane * 4) = acc[g];
        }
    }
    {
        __syncthreads();
        LAS float* scr = (LAS float*)(F.lds + F.wave * 16640);
        constexpr int I_IN = (DM / 64) * (IN_COLS / 64), I_O = (DM / 64) * (DM / 64), I_G = (DM / 64) * (DFF / 64), I_D = (DFF / 64) * (DM / 64), I_UK = (256 / 64) * (1024 / 64);
        constexpr int PER_L = I_IN + I_O + 2 * I_G + I_D + 2 * I_UK;
        struct TrDesc { const float* W; bf16* WT; unsigned char* W8; int K, N, kind, row_off, k0, n0; };
        auto decode = [&](int it) -> TrDesc {
            TrDesc t; const int l = it / PER_L; int r = it % PER_L;
            t.W8 = (unsigned char*)(F.ws + WS_WIN8 + (size_t)l * SZ_WIN8);
            if (r < I_IN) { t.W = pin(F, I_WIN) + (size_t)l * DM * IN_COLS; t.WT = (bf16*)(F.ws + WS_WIN + (size_t)l * SZ_WIN); t.K = DM; t.N = IN_COLS; t.kind = 1; t.row_off = 0; }
            else if ((r -= I_IN) < I_O) { t.W = pin(F, I_WO) + (size_t)l * DM * DM; t.WT = (bf16*)(F.ws + WS_WO + (size_t)l * SZ_WO); t.K = DM; t.N = DM; t.kind = 0; t.row_off = 0; }
            else if ((r -= I_O) < I_G) { t.W = pin(F, I_WG) + (size_t)l * DM * DFF; t.WT = (bf16*)(F.ws + WS_WGU + (size_t)l * SZ_WGU); t.K = DM; t.N = DFF; t.kind = 2; t.row_off = 0; }
            else if ((r -= I_G) < I_G) { t.W = pin(F, I_WU) + (size_t)l * DM * DFF; t.WT = (bf16*)(F.ws + WS_WGU + (size_t)l * SZ_WGU); t.K = DM; t.N = DFF; t.kind = 3; t.row_off = 0; }
            else if ((r -= I_G) < I_D) { t.W = pin(F, I_WD) + (size_t)l * DFF * DM; t.WT = (bf16*)(F.ws + WS_WD + (size_t)l * SZ_WD); t.K = DFF; t.N = DM; t.kind = 0; t.row_off = 0; }
            else if ((r -= I_D) < I_UK) { t.W = pin(F, I_WUK) + (size_t)l * 256 * 1024; t.WT = (bf16*)(F.ws + WS_WUKV + (size_t)l * SZ_WUKV); t.K = 256; t.N = 1024; t.kind = 0; t.row_off = 0; }
            else { r -= I_UK; t.W = pin(F, I_WUV) + (size_t)l * 256 * 1024; t.WT = (bf16*)(F.ws + WS_WUKV + (size_t)l * SZ_WUKV); t.K = 256; t.N = 1024; t.kind = 0; t.row_off = 1024; }
            const int nblk = t.N >> 6; t.k0 = 64 * (r / nblk); t.n0 = 64 * (r % nblk); return t;
        };
        const int lr = lane >> 4, lc = (lane & 15) * 4, c8 = lane & 7;
#define TR_LOAD(T, V) do { _Pragma("unroll") for (int i_ = 0; i_ < 16; ++i_) V[i_] = __builtin_nontemporal_load((const GAS f32x4*)((T).W + (size_t)((T).k0 + 4 * i_ + lr) * (T).N + (T).n0 + lc)); } while (0)
#define TR_FINISH(T, V) do { \
        _Pragma("unroll") for (int i_ = 0; i_ < 16; ++i_) { LAS float* d_ = scr + (4 * i_ + lr) * 65 + lc; d_[0] = V[i_][0]; d_[1] = V[i_][1]; d_[2] = V[i_][2]; d_[3] = V[i_][3]; } \
        LDS_WAIT(); asm volatile("" ::: "memory"); \
        _Pragma("unroll") for (int j_ = 0; j_ < 8; ++j_) { const int n_ = (T).n0 + (lane >> 3) + 8 * j_; const LAS float* s_ = scr + (8 * c8) * 65 + (lane >> 3) + 8 * j_; \
            const int dr_ = (T).kind == 1 ? win_dest(n_) : (T).kind == 2 ? ((n_ >> 7) << 8) + (n_ & 127) : (T).kind == 3 ? ((n_ >> 7) << 8) + 128 + (n_ & 127) : n_ + (T).row_off; \
            *(GAS v4u*)((T).WT + (size_t)dr_ * (T).K + (T).k0 + 8 * c8) = (v4u){pk2(s_[0 * 65], s_[1 * 65]), pk2(s_[2 * 65], s_[3 * 65]), pk2(s_[4 * 65], s_[5 * 65]), pk2(s_[6 * 65], s_[7 * 65])}; \
            if ((T).kind == 1) *(GAS v2u*)((GAS unsigned char*)(T).W8 + (size_t)dr_ * (T).K + (T).k0 + 8 * c8) = pg8::pk8_fp8(32.f * s_[0 * 65], 32.f * s_[1 * 65], 32.f * s_[2 * 65], 32.f * s_[3 * 65], 32.f * s_[4 * 65], 32.f * s_[5 * 65], 32.f * s_[6 * 65], 32.f * s_[7 * 65]);     } \
        LDS_WAIT(); asm volatile("" ::: "memory"); } while (0)
        {
            constexpr int NIT = DEPTH * PER_L;
            f32x4 va[16], vb[16]; TrDesc ta, tb; int it = gw;
            if (it < NIT) { ta = decode(it); TR_LOAD(ta, va); }
            while (it < NIT) {
                const int it1 = it + NGW, it2 = it + 2 * NGW;
                if (it1 < NIT) { tb = decode(it1); TR_LOAD(tb, vb); }
                TR_FINISH(ta, va);
                if (it1 >= NIT) break;
                if (it2 < NIT) { ta = decode(it2); TR_LOAD(ta, va); }
                TR_FINISH(tb, vb);
                it = it2;
            }
        }
#undef TR_LOAD
#undef TR_FINISH
        for (int i = gt; i < DEPTH * 49152; i += NGT) { const int l = i / 49152, q = i % 49152;
            *(GAS v4u*)((bf16*)(F.ws + WS_WIN + (size_t)l * SZ_WIN) + (size_t)IN_COLS * DM + (size_t)q * 8) = (v4u){0u, 0u, 0u, 0u}; }
    }
    for (int i = gt; i < DEPTH * 4 * 256 * 104; i += NGT) {
        const int q = i % 104, row = i / 104, j = row & 255, b = (row >> 8) & 3, l = row >> 10;
        const size_t krow = (size_t)NCTX + (size_t)b * 2304 + j, src_row = ((size_t)b * DEPTH + l) * 256 + j;
        if (q < 32) { const int h = q >> 4, p0 = (q & 15) * 8, i0 = p0 >> 1; const float* s = pin(F, I_CKA) + (src_row * 2 + h) * 128;
            const f32x4 lo = *(const f32x4*)(s + i0), hi = *(const f32x4*)(s + 64 + i0);
            *(GAS v2u*)((GAS unsigned char*)(F.ws + WS_KA + (size_t)l * SZ_KA) + krow * 256 + h * 128 + p0) = pg8::pk8_fp8(lo[0], hi[0], lo[1], hi[1], lo[2], hi[2], lo[3], hi[3]); }
        else if (q < 96) { const bool isv = q < 64; const int c0 = (isv ? q - 32 : q - 64) * 8; const float* s = (isv ? pin(F, I_CVA) : pin(F, I_CCKV)) + src_row * 256 + c0;
            const f32x4 a = *(const f32x4*)s, c = *(const f32x4*)(s + 4);
            if (isv) *(GAS v2u*)((GAS unsigned char*)(F.ws + WS_VA + (size_t)l * SZ_KA) + krow * 256 + c0) = pg8::pk8_fp8(a[0], a[1], a[2], a[3], c[0], c[1], c[2], c[3]);
            else *(GAS v4u*)((bf16*)(F.ws + WS_CKV + (size_t)l * SZ_KA) + krow * 256 + c0) = (v4u){pk2(a[0], a[1]), pk2(a[2], a[3]), pk2(c[0], c[1]), pk2(c[2], c[3])}; }
        else { const int p0 = (q - 96) * 8, i0 = p0 >> 1; const float* s = pin(F, I_CKR) + src_row * 64;
            const f32x4 lo = *(const f32x4*)(s + i0), hi = *(const f32x4*)(s + 32 + i0);
            *(GAS v2u*)((GAS unsigned char*)(F.ws + WS_KR + (size_t)l * SZ_KR) + krow * 64 + p0) = pg8::pk8_fp8(lo[0], hi[0], lo[1], hi[1], lo[2], hi[2], lo[3], hi[3]); }
    }
}
__device__ __forceinline__ void p1_modreduce(const Frame F) {
    const int gt = F.vcu * (NWAVES * 64) + opaque_tid(), NGT = F.G * NWAVES * 64;
    const float* part = (const float*)(F.ws + WS_PART); float* mod = (float*)(F.ws + WS_MOD);
    for (int i = gt; i < DEPTH * NGRP * MODW / 4; i += NGT) {
        const int e4 = i % (MODW / 4), lg = i / (MODW / 4), l = lg / NGRP;
        f32x4 s = *(const f32x4*)(pin(F, I_BADA) + (size_t)l * MODW + e4 * 4);
        for (int kc = 0; kc < KCH; ++kc) s += *(const f32x4*)(part + ((size_t)kc * DEPTH * NGRP + lg) * MODW + e4 * 4);
        *(f32x4*)(mod + (size_t)lg * MODW + e4 * 4) = s;
    }
}
template <int MODE>
__device__ __forceinline__ void norm_phase(const Frame F, int l) {
    const int lane = opaque_tid() & 63;
    int gw = F.vcu * NWAVES + F.wave; asm volatile("" : "+s"(gw));
    const int NGW = F.G * NWAVES;
    bf16* X = (bf16*)(F.ws + WS_X); bf16* XN = (bf16*)(F.ws + WS_XN); const float* mod = (const float*)(F.ws + WS_MOD);
    for (int rb = gw; rb < MTOK / 8; rb += NGW) {
        const int r0 = rb * 8, grp = r0 < NCTX ? 0 : 1 + ((r0 - NCTX) >> 11);
        f32x4 a[8], s[8];
        if (MODE == 2) {
#pragma unroll
            for (int j = 0; j < 8; ++j) { a[j] = *(const f32x4*)(pin(F, I_NF) + 8 * lane + 512 * (j >> 1) + 4 * (j & 1)); s[j] = (f32x4){0.f, 0.f, 0.f, 0.f}; }
        } else {
            const float* md = mod + ((size_t)l * NGRP + grp) * MODW + (MODE == 1 ? 3 * DM : 0);
            const float* nw = pin(F, MODE == 1 ? I_NFFN : I_NATT) + (size_t)l * DM;
#pragma unroll
            for (int j = 0; j < 8; ++j) { const int c = 8 * lane + 512 * (j >> 1) + 4 * (j & 1); a[j] = *(const f32x4*)(nw + c) * (*(const f32x4*)(md + DM + c) + 1.0f); s[j] = *(const f32x4*)(md + c); }
        }
        for (int rr = 0; rr < 8; rr += 2) {
            f32x4 v[2][8];
#pragma unroll
            for (int q = 0; q < 2; ++q) { const int r = r0 + rr + q;
                if (MODE == 0 && l == 0) {
                    const float* src = r < NCTX ? pin(F, I_XP) + (size_t)r * DM : pin(F, I_XS) + (size_t)(r - NCTX) * DM;
#pragma unroll
                    for (int j = 0; j < 8; ++j) v[q][j] = *(const f32x4*)(src + 8 * lane + 512 * (j >> 1) + 4 * (j & 1));
                } else {
#pragma unroll
                    for (int j = 0; j < 4; ++j) { const v4u w = *(const v4u*)(X + (size_t)r * DM + 8 * lane + 512 * j);
                        v[q][2 * j] = (f32x4){__uint_as_float(w.x << 16), __uint_as_float(w.x & 0xffff0000u), __uint_as_float(w.y << 16), __uint_as_float(w.y & 0xffff0000u)};
                        v[q][2 * j + 1] = (f32x4){__uint_as_float(w.z << 16), __uint_as_float(w.z & 0xffff0000u), __uint_as_float(w.w << 16), __uint_as_float(w.w & 0xffff0000u)}; }
                } }
#pragma unroll
            for (int q = 0; q < 2; ++q) { const int r = r0 + rr + q; float ss = 0.f;
                if (MODE == 0 && l == 0) {
#pragma unroll
                    for (int j = 0; j < 4; ++j) *(v4u*)(X + (size_t)r * DM + 8 * lane + 512 * j) = (v4u){pk2(v[q][2 * j][0], v[q][2 * j][1]), pk2(v[q][2 * j][2], v[q][2 * j][3]), pk2(v[q][2 * j + 1][0], v[q][2 * j + 1][1]), pk2(v[q][2 * j + 1][2], v[q][2 * j + 1][3])};
                }
#pragma unroll
                for (int j = 0; j < 8; ++j) ss += (v[q][j][0] * v[q][j][0] + v[q][j][1] * v[q][j][1]) + (v[q][j][2] * v[q][j][2] + v[q][j][3] * v[q][j][3]);
                const float rstd = 1.0f / sqrtf(wave_sum(ss, lane) * (1.0f / DM) + 1e-6f);
                if (MODE == 2) {
#pragma unroll
                    for (int j = 0; j < 8; ++j) *(f32x4*)((float*)pin(F, 23) + OUT_Y + (size_t)r * DM + 8 * lane + 512 * (j >> 1) + 4 * (j & 1)) = v[q][j] * rstd * a[j];
                } else {
#pragma unroll
                    for (int j = 0; j < 4; ++j) { const f32x4 y0 = v[q][2 * j] * rstd * a[2 * j] + s[2 * j], y1 = v[q][2 * j + 1] * rstd * a[2 * j + 1] + s[2 * j + 1];
                        *(v4u*)(XN + (size_t)r * DM + 8 * lane + 512 * j) = (v4u){pk2(y0[0], y0[1]), pk2(y0[2], y0[3]), pk2(y1[0], y1[1]), pk2(y1[2], y1[3])};
                        if (MODE == 0) *(GAS v2u*)((GAS unsigned char*)(F.ws + WS_XN8) + (size_t)r * DM + 8 * lane + 512 * j) = pg8::pk8_fp8(y0[0], y0[1], y0[2], y0[3], y1[0], y1[1], y1[2], y1[3]); }
                } }
        }
    }
}
__device__ __forceinline__ void attn_phase(const Frame F, int l) {
    const unsigned char* Qa = (const unsigned char*)(F.ws + WS_QA); const unsigned char* Qbn = (const unsigned char*)(F.ws + WS_QBN); const unsigned char* Qbr = (const unsigned char*)(F.ws + WS_QBR);
    const unsigned char* Ka = (const unsigned char*)(F.ws + WS_KA + (size_t)l * SZ_KA); const unsigned char* Kr = (const unsigned char*)(F.ws + WS_KR + (size_t)l * SZ_KR); const unsigned char* Kbn = (const unsigned char*)(F.ws + WS_KBN);
    const unsigned char* Va = (const unsigned char*)(F.ws + WS_VA + (size_t)l * SZ_KA); const unsigned char* Vb = (const unsigned char*)(F.ws + WS_VB);
    bf16* O = (bf16*)(F.ws + WS_O);
    LAS char* lds = (LAS char*)(F.lds + RING_OFF);
    for (int pass = 0; pass < 2; ++pass)
        for (int u = F.vcu; u < 256; u += F.G) {
            const int h = pass == 0 ? ((u >> 3) & 7) : (u & 7);
            const size_t r0 = pass == 0 ? (size_t)NCTX + (size_t)(u >> 6) * 2048 + (size_t)(u & 7) * 256 : (size_t)(u >> 3) * 256;
            const size_t k0 = pass == 0 ? (size_t)NCTX + (size_t)(u >> 6) * 2304 : r0;
            const int seq = pass == 0 ? 2304 : 256;
            att::attn_unit<true, 1024, 2>(Qbn + r0 * 1024 + h * 128, Qbr + r0 * 512 + h * 64, Kbn + k0 * 1024 + h * 128, Kr + k0 * 64, Vb + k0 * 1024 + h * 128, O + r0 * 2048 + 1024 + h * 128, seq, lds);
        }
    for (int pass = 0; pass < 2; ++pass)
        for (int u = F.vcu; u < 256; u += F.G) {
            const int h = pass == 0 ? ((u >> 3) & 7) : (u & 7);
            const size_t r0 = pass == 0 ? (size_t)NCTX + (size_t)(u >> 6) * 2048 + (size_t)(u & 7) * 256 : (size_t)(u >> 3) * 256;
            const size_t k0 = pass == 0 ? (size_t)NCTX + (size_t)(u >> 6) * 2304 : r0;
            const int seq = pass == 0 ? 2304 : 256;
            att::attn_unit<false, 256, 2>(Qa + r0 * 1024 + h * 128, nullptr, Ka + k0 * 256 + (h >> 2) * 128, nullptr, Va + k0 * 256 + (h >> 2) * 128, O + r0 * 2048 + h * 128, seq, lds);
        }
}

enum { PH_PRO = 0, PH_MOD = 1, PH_L0 = 2, PH_PER_L = 8, PH_FINAL = PH_L0 + PH_PER_L * DEPTH, N_PH = PH_FINAL + 1 };
__global__ void __launch_bounds__(NWAVES * 64, 2) mk_fwd(Args args) {
    extern __shared__ __attribute__((aligned(16))) unsigned char lds[];
    Frame F;
    F.lds = (LAS unsigned char*)lds;
    volatile LAS unsigned* MISC = (volatile LAS unsigned*)(F.lds + MISC_OFF);
    F.wave = __builtin_amdgcn_readfirstlane((int)threadIdx.x >> 6);
    F.G = gridDim.x; { const int bx = blockIdx.x; F.vcu = (F.G % 8 == 0) ? (bx % 8) * (F.G / 8) + bx / 8 : bx; }
    F.ws = (GAS unsigned char*)args.ws;
    for (int u = threadIdx.x; u < (LDS_BYTES - MISC_OFF) / 4; u += NWAVES * 64) ((LAS unsigned*)(F.lds + MISC_OFF))[u] = 0u;
    __syncthreads();
    const int lo = args.ph_lo, hi = args.ph_hi;
    unsigned* barw = (unsigned*)(args.ws + WS_CTL) + CW_BAR;
    XcdBarrier bar; bar.bar = barw; bar.x = 0; bar.st = nullptr;
    if (hi - lo > 1) bar = xcd_barrier_post(barw, MISC + 8);
#define IN(k) (lo <= (k) && (k) < hi)
#define SEAM(k) do { if (IN(k) && IN((k) + 1)) { XcdBarrier b_ = bar; GAS unsigned* bw_ = (GAS unsigned*)b_.bar; volatile LAS unsigned* st_ = b_.st; \
    asm volatile("" : "+s"(bw_), "+s"(b_.x), "+s"(st_)); b_.bar = (unsigned*)bw_; b_.st = st_; xcd_barrier(b_); } } while (0)

    if (IN(PH_PRO)) p0_prologue(fresh(F));
    SEAM(PH_PRO);
    if (IN(PH_MOD)) p1_modreduce(fresh(F));
    SEAM(PH_MOD);
    for (int l = 0; l < DEPTH; ++l) {
        const int pb = PH_L0 + PH_PER_L * l;
        if (IN(pb + 0)) norm_phase<0>(fresh(F), l);
        SEAM(pb + 0);
        if (IN(pb + 1)) {
            const Frame P = fresh(F);
            if (P.G == 256) {
                const int bx = (int)blockIdx.x;
#ifdef MK_SKEW_IN
                if ((bx >> 3) < 24 && ((bx >> 3) & 1)) __builtin_amdgcn_s_sleep(MK_SKEW_IN);
#endif
                { pg8::Gemm g{(const bf16*)(P.ws + WS_XN), (const bf16*)(P.ws + WS_WIN + (size_t)l * SZ_WIN), MTOK, INP, DM}; pg8::InOrderB S{bx & 7, bx >> 3};
                  pg8::EpiIn E; E.lds = P.lds; E.ws = P.ws; E.l = l; E.pn_base = 0;
                  pg8::gemm_phase<pg8::EpiIn, pg8::InOrderB, true, true>(P.lds + RING_OFF, g, S, E); }
                if ((bx >> 3) >= 24) {
                    int kukv = 256; asm volatile("" : "+s"(kukv));
                    pg8::Gemm g{(const bf16*)(P.ws + WS_CKV + (size_t)l * SZ_KA), (const bf16*)(P.ws + WS_WUKV + (size_t)l * SZ_WUKV), KROWS, 2048, kukv}; pg8::UkvOrder S{bx & 7, (bx >> 3) - 24, 0};
                    pg8::EpiUkv E{(unsigned char*)(P.ws + WS_KBN), (unsigned char*)(P.ws + WS_VB)};
                    pg8::gemm_phase<pg8::EpiUkv, pg8::UkvOrder, true, true>(P.lds + RING_OFF, g, S, E);
                }
                { pg8::Gemm g{(const bf16*)(P.ws + WS_XN8), (const bf16*)(P.ws + WS_WIN8 + (size_t)l * SZ_WIN8), MTOK, INP, DM}; pg8::InOrderQ S{bx & 7, bx >> 3};
                  pg8::EpiIn E; E.lds = P.lds; E.ws = P.ws; E.l = l; E.pn_base = 0;
                  pg8::gemm_phase<pg8::EpiIn, pg8::InOrderQ, true, true, true, 0x7A7A7A7A, 0x7F7F7F7F>(P.lds + RING_OFF, g, S, E); }
                if ((bx & 7) >= 4 && (bx >> 3) < 8) {
                    int kukv = 256; asm volatile("" : "+s"(kukv));
                    pg8::Gemm g{(const bf16*)(P.ws + WS_CKV + (size_t)l * SZ_KA), (const bf16*)(P.ws + WS_WUKV + (size_t)l * SZ_WUKV), KROWS, 2048, kukv}; pg8::UkvOrder S{bx & 7, bx >> 3, 1};
                    pg8::EpiUkv E{(unsigned char*)(P.ws + WS_KBN), (unsigned char*)(P.ws + WS_VB)};
                    pg8::gemm_phase<pg8::EpiUkv, pg8::UkvOrder, true, true>(P.lds + RING_OFF, g, S, E);
                }
            } else {
                { pg8::Gemm g{(const bf16*)(P.ws + WS_XN), (const bf16*)(P.ws + WS_WIN + (size_t)l * SZ_WIN), MTOK, INP, DM}; pg8::StaticOrder S; S.init(MTOK, INP, P.G, (int)blockIdx.x);
                  pg8::EpiIn E; E.lds = P.lds; E.ws = P.ws; E.l = l; E.pn_base = 0;
                  pg8::gemm_phase<pg8::EpiIn, pg8::StaticOrder, true, true>(P.lds + RING_OFF, g, S, E); }
            }
        }
        SEAM(pb + 1);
        if (IN(pb + 2)) {
            const Frame P = fresh(F);
            if (P.G != 256) {
                int kukv = 256; asm volatile("" : "+s"(kukv));
                pg8::Gemm g{(const bf16*)(P.ws + WS_CKV + (size_t)l * SZ_KA), (const bf16*)(P.ws + WS_WUKV + (size_t)l * SZ_WUKV), KROWS, 2048, kukv}; pg8::StaticOrder S; S.init(KROWS, 2048, P.G, (int)blockIdx.x);
                pg8::EpiUkv E{(unsigned char*)(P.ws + WS_KBN), (unsigned char*)(P.ws + WS_VB)};
                pg8::gemm_phase<pg8::EpiUkv, pg8::StaticOrder, true, true>(P.lds + RING_OFF, g, S, E);
            }
        }
        if (F.G != 256) SEAM(pb + 2);
        if (IN(pb + 3)) attn_phase(fresh(F), l);
        SEAM(pb + 3);
        if (IN(pb + 4)) {
            const Frame P = fresh(F);
            pg8::Gemm g{(const bf16*)(P.ws + WS_O), (const bf16*)(P.ws + WS_WO + (size_t)l * SZ_WO), MTOK, DM, DM}; pg8::StaticOrder S; S.init(MTOK, DM, P.G, (int)blockIdx.x);
            pg8::EpiRes E{(bf16*)(P.ws + WS_X), (const float*)(P.ws + WS_MOD) + (size_t)l * NGRP * MODW + 2 * DM};
            pg8::gemm_phase<pg8::EpiRes, pg8::StaticOrder, true, true>(P.lds + RING_OFF, g, S, E);
        }
        SEAM(pb + 4);
        if (IN(pb + 5)) norm_phase<1>(fresh(F), l);
        SEAM(pb + 5);
        if (IN(pb + 6)) {
            const Frame P = fresh(F);
            pg8::Gemm g{(const bf16*)(P.ws + WS_XN), (const bf16*)(P.ws + WS_WGU + (size_t)l * SZ_WGU), MTOK, NGU, DM}; pg8::StaticOrder S; S.init(MTOK, NGU, P.G, (int)blockIdx.x);
            pg8::EpiSwiglu E{(bf16*)(P.ws + WS_H)};
            { const int g_ = ((int)blockIdx.x >> 3) & 3; if (g_ == 1) __builtin_amdgcn_s_sleep(16); else if (g_ == 2) __builtin_amdgcn_s_sleep(32); else if (g_ == 3) __builtin_amdgcn_s_sleep(48); }
            pg8::gemm_phase<pg8::EpiSwiglu, pg8::StaticOrder, true, true>(P.lds + RING_OFF, g, S, E);
        }
        SEAM(pb + 6);
        if (IN(pb + 7)) {
            const Frame P = fresh(F);
            pg8::Gemm g{(const bf16*)(P.ws + WS_H), (const bf16*)(P.ws + WS_WD + (size_t)l * SZ_WD), MTOK, DM, DFF}; pg8::StaticOrder S; S.init(MTOK, DM, P.G, (int)blockIdx.x);
            pg8::EpiRes E{(bf16*)(P.ws + WS_X), (const float*)(P.ws + WS_MOD) + (size_t)l * NGRP * MODW + 5 * DM};
            pg8::gemm_phase<pg8::EpiRes, pg8::StaticOrder, true, true>(P.lds + RING_OFF, g, S, E);
        }
        SEAM(pb + 7);
    }
    if (IN(PH_FINAL)) norm_phase<2>(fresh(F), 0);
#undef IN
#undef SEAM
}

#ifndef MK_ONE_LAUNCH
#define MK_ONE_LAUNCH 1
#endif
extern "C" void kernel_launch(void* const* d_in, const int* in_sizes, int n_in, void* d_out, int out_size, void* d_ws, size_t ws_size, hipStream_t stream) {
    static int grid = 0;
    if (grid == 0) {
        if (n_in != 23 || (size_t)out_size != OUT_TOTAL || ws_size < WS_END) { fprintf(stderr, "kernel_launch: shape mismatch: n_in %d out %d ws %zu (need %zu)\n", n_in, out_size, ws_size, (size_t)WS_END); grid = -1; return; }
        int dev = 0, cus = 0, per_cu = 0;
        if (hipGetDevice(&dev) != hipSuccess || hipDeviceGetAttribute(&cus, hipDeviceAttributeMultiprocessorCount, dev) != hipSuccess) { grid = -1; return; }
        if (hipFuncSetAttribute((const void*)mk_fwd, hipFuncAttributeMaxDynamicSharedMemorySize, LDS_BYTES) != hipSuccess) { fprintf(stderr, "kernel_launch: hipFuncSetAttribute failed\n"); grid = -1; return; }
        if (hipOccupancyMaxActiveBlocksPerMultiprocessor(&per_cu, (const void*)mk_fwd, NWAVES * 64, LDS_BYTES) != hipSuccess || per_cu < 1) fprintf(stderr, "kernel_launch: occupancy query reports %d\n", per_cu);
        (void)hipGetLastError();
        grid = cus;
    }
    if (grid < 0) return;
    if (hipMemsetAsync((char*)d_ws + WS_CTL, 0, CTL_ZERO_BYTES, stream) != hipSuccess) return;
    Args a{};
    for (int i = 0; i < 23; ++i) a.in[i] = (const float*)d_in[i];
    a.out = (float*)d_out; a.ws = (unsigned char*)d_ws;
#if MK_ONE_LAUNCH
    a.ph_lo = 0; a.ph_hi = N_PH;
    hipLaunchKernelGGL(mk_fwd, dim3(grid), dim3(NWAVES * 64), LDS_BYTES, stream, a);
#else
    for (int p = 0; p < N_PH; ++p) { a.ph_lo = p; a.ph_hi = p + 1; hipLaunchKernelGGL(mk_fwd, dim3(grid), dim3(NWAVES * 64), LDS_BYTES, stream, a); }
#endif
    const hipError_t le = hipPeekAtLastError();
    if (le != hipSuccess) fprintf(stderr, "kernel_launch: launch failed: %s\n", hipGetErrorName(le));
}
```

```cpp
#include <hip/hip_runtime.h>
#include <cstdio>
#include <cstdint>


namespace pg8 {
#define PG8_LAS __attribute__((address_space(3)))
typedef unsigned short bf16_t;
typedef short bf16x8 __attribute__((ext_vector_type(8)));
typedef float f32x4 __attribute__((ext_vector_type(4)));
typedef unsigned u32x4 __attribute__((ext_vector_type(4)));
typedef int pg8_i32x4 __attribute__((ext_vector_type(4)));
constexpr int BM = 256, BK = 64, HALF = 128, HTB = HALF * BK * 2  , STAGE_BYTES = 8 * HTB, NXCD = 8, WGM = 8;

__host__ __device__ __forceinline__ int lds_byte(int r, int c) { const int st = (r >> 4) * 2 + (c >> 5), rr = r & 15, cc = c & 31, ob = rr * 64 + cc * 2; return st * 1024 + (ob ^ (((ob >> 9) & 1) << 5)); }
__host__ __device__ __forceinline__ void stage_rc(int b, int& R, int& C) { const int st = b / 1024, sb = b % 1024, swz = sb ^ (((sb >> 9) & 1) << 5); R = (st >> 1) * 16 + swz / 64; C = (st & 1) * 32 + (swz % 64) / 2; }
__host__ __device__ __forceinline__ int perm32(int rho) { const int n = rho >> 4, i = rho & 15; return 8 * (i >> 2) + 4 * n + (i & 3); }

struct Unit { int pm, pn; };
struct Gemm { const bf16_t* A; const bf16_t* Bt; int M, N, K; };

struct StaticOrder {
    int nM, nN, nwg, G, c;
    __host__ __device__ void init(int M, int N, int G_, int c_) { nM = M / BM; nN = N / BM; nwg = nM * nN; G = G_; c = c_; }
    __host__ __device__ bool next(int i, Unit& u) const {
        const long L = (long)i * G + c; if (L >= nwg) return false;
        int wgid = (int)L; { const int q = nwg / NXCD, r = nwg % NXCD, xcd = wgid % NXCD, off = wgid / NXCD; wgid = (xcd < r ? xcd * (q + 1) : r * (q + 1) + (xcd - r) * q) + off; }
        const int nig = WGM * nN, gid = wgid / nig, fm = gid * WGM, gsz = (nM - fm) < WGM ? (nM - fm) : WGM;
        u.pm = fm + ((wgid % nig) % gsz); u.pn = (wgid % nig) / gsz; return true;
    }
    __device__ __forceinline__ void a_ready(const Unit&) const {}
    __device__ __forceinline__ void done(const Unit&) const {}
};

__device__ __forceinline__ unsigned cvt_pk_bf16(float lo, float hi) { unsigned r; asm volatile("v_cvt_pk_bf16_f32 %0, %1, %2" : "=v"(r) : "v"(lo), "v"(hi)); return r; }
typedef float f32x2 __attribute__((ext_vector_type(2)));


typedef unsigned u32x2 __attribute__((ext_vector_type(2)));
struct EpiBf16Split {
    static constexpr bool PERM = true, AFTER_DRAIN = false;
    bf16_t* O; int ldc; int split_cols; size_t split_stride;
    __device__ __forceinline__ void operator()(const f32x4 (&acc)[2][2][4][2], const Unit& u, int wr, int wc, int fr, int fq) const {
        { int t_ = threadIdx.x; asm volatile("" : "+v"(t_)); fr = t_ & 15; fq = (t_ >> 4) & 3; }
        const int row0 = u.pm * BM + wr * 64 + fr; int colt = u.pn * BM; bf16_t* base = O;
        if (split_cols) { const int t = colt / split_cols; base += (size_t)t * split_stride; colt -= t * split_cols; }
        const int col0 = colt + wc * 32 + 8 * fq;
#pragma unroll
        for (int ai = 0; ai < 2; ++ai)
#pragma unroll
            for (int m = 0; m < 4; ++m) { bf16_t* rowp = base + (size_t)(row0 + ai * HALF + m * 16) * ldc + col0;
#pragma unroll
                for (int bj = 0; bj < 2; ++bj) { const f32x4 v0 = acc[ai][bj][m][0], v1 = acc[ai][bj][m][1];
                    u32x4 w; w.x = cvt_pk_bf16(v0[0], v0[1]); w.y = cvt_pk_bf16(v0[2], v0[3]); w.z = cvt_pk_bf16(v1[0], v1[1]); w.w = cvt_pk_bf16(v1[2], v1[3]);
                    *(u32x4*)(rowp + bj * HALF) = w; } }
    }
};

struct EpiRes {
    static constexpr bool PERM = true, AFTER_DRAIN = false;
    bf16_t* X; const float* gate;
    __device__ __forceinline__ void operator()(const f32x4 (&acc)[2][2][4][2], const Unit& u, int wr, int wc, int fr, int fq) const {
        { int t_ = threadIdx.x; asm volatile("" : "+v"(t_)); fr = t_ & 15; fq = (t_ >> 4) & 3; }
        const int grp = u.pm < 32 ? 0 : 1 + ((u.pm - 32) >> 3);
        const int col0 = u.pn * BM + wc * 32 + 8 * fq;
        const float* gv = gate + (size_t)grp * 12288 + col0;
        f32x4 g[2][2];
#pragma unroll
        for (int bj = 0; bj < 2; ++bj)
#pragma unroll
            for (int n = 0; n < 2; ++n) g[bj][n] = *(const f32x4*)(gv + bj * HALF + 4 * n);
        u32x4 xr[2][4][2];
#pragma unroll
        for (int ai = 0; ai < 2; ++ai)
#pragma unroll
            for (int m = 0; m < 4; ++m) { const bf16_t* xp = X + (size_t)(u.pm * BM + ai * HALF + wr * 64 + m * 16 + fr) * 2048 + col0;
#pragma unroll
                for (int bj = 0; bj < 2; ++bj) xr[ai][m][bj] = *(const u32x4*)(xp + bj * HALF); }
#pragma unroll
        for (int ai = 0; ai < 2; ++ai)
#pragma unroll
            for (int m = 0; m < 4; ++m) { bf16_t* xp = X + (size_t)(u.pm * BM + ai * HALF + wr * 64 + m * 16 + fr) * 2048 + col0;
#pragma unroll
                for (int bj = 0; bj < 2; ++bj) { const u32x4 r = xr[ai][m][bj];
                    f32x4 x0 = (f32x4){__uint_as_float(r.x << 16), __uint_as_float(r.x & 0xffff0000u), __uint_as_float(r.y << 16), __uint_as_float(r.y & 0xffff0000u)};
                    f32x4 x1 = (f32x4){__uint_as_float(r.z << 16), __uint_as_float(r.z & 0xffff0000u), __uint_as_float(r.w << 16), __uint_as_float(r.w & 0xffff0000u)};
                    x0 = x0 + g[bj][0] * acc[ai][bj][m][0]; x1 = x1 + g[bj][1] * acc[ai][bj][m][1];
                    u32x4 w; w.x = cvt_pk_bf16(x0[0], x0[1]); w.y = cvt_pk_bf16(x0[2], x0[3]); w.z = cvt_pk_bf16(x1[0], x1[1]); w.w = cvt_pk_bf16(x1[2], x1[3]);
                    *(u32x4*)(xp + bj * HALF) = w; } }
    }
};

struct EpiSwiglu {
    static constexpr bool PERM = true, AFTER_DRAIN = false;
    bf16_t* H;
    __device__ __forceinline__ void operator()(const f32x4 (&acc)[2][2][4][2], const Unit& u, int wr, int wc, int fr, int fq) const {
        { int t_ = threadIdx.x; asm volatile("" : "+v"(t_)); fr = t_ & 15; fq = (t_ >> 4) & 3; }
        const int f0 = u.pn * 128 + wc * 32 + 8 * fq;
#pragma unroll
        for (int ai = 0; ai < 2; ++ai)
#pragma unroll
            for (int m = 0; m < 4; ++m) { bf16_t* rowp = H + (size_t)(u.pm * BM + ai * HALF + wr * 64 + m * 16 + fr) * 5632 + f0;
                float h[2][4];
#pragma unroll
                for (int n = 0; n < 2; ++n) { const f32x4 a = acc[ai][0][m][n], b = acc[ai][1][m][n];
#pragma unroll
                    for (int e = 0; e < 4; ++e) h[n][e] = a[e] * __builtin_amdgcn_rcpf(1.0f + __builtin_amdgcn_exp2f(a[e] * -1.4426950408889634f)) * b[e]; }
                u32x4 w; w.x = cvt_pk_bf16(h[0][0], h[0][1]); w.y = cvt_pk_bf16(h[0][2], h[0][3]); w.z = cvt_pk_bf16(h[1][0], h[1][1]); w.w = cvt_pk_bf16(h[1][2], h[1][3]);
                *(u32x4*)rowp = w; }
    }
};

struct EpiUkv {
    static constexpr bool PERM = true, AFTER_DRAIN = false;
    unsigned char* K8; unsigned char* V8;
    __device__ __forceinline__ void operator()(const f32x4 (&acc)[2][2][4][2], const Unit& u, int wr, int wc, int fr, int fq) const {
        { int t_ = threadIdx.x; asm volatile("" : "+v"(t_)); fr = t_ & 15; fq = (t_ >> 4) & 3; }
        const int row0 = u.pm * BM + wr * 64 + fr, col0 = (u.pn & 3) * BM + wc * 32 + 8 * fq;
        unsigned char* dst = u.pn < 4 ? K8 : V8;
#pragma unroll
        for (int ai = 0; ai < 2; ++ai)
#pragma unroll
            for (int m = 0; m < 4; ++m) { const size_t ro = (size_t)(row0 + ai * HALF + m * 16) * 1024 + col0;
#pragma unroll
                for (int bj = 0; bj < 2; ++bj) { const f32x4 v0 = acc[ai][bj][m][0], v1 = acc[ai][bj][m][1];
                    int lo = __builtin_amdgcn_cvt_pk_fp8_f32(v0[0], v0[1], 0, false); lo = __builtin_amdgcn_cvt_pk_fp8_f32(v0[2], v0[3], lo, true);
                    int hi = __builtin_amdgcn_cvt_pk_fp8_f32(v1[0], v1[1], 0, false); hi = __builtin_amdgcn_cvt_pk_fp8_f32(v1[2], v1[3], hi, true);
                    *(u32x2*)(dst + ro + bj * HALF) = (u32x2){(unsigned)lo, (unsigned)hi}; } }
    }
};

struct InOrderB {
    int x, w;
    __device__ __forceinline__ bool next(int i, Unit& u) const {
        if (i >= 1) return false;
        if (w < 24) { u.pm = 8 * x + (w & 7); const int g = w >> 3; u.pn = g == 0 ? 4 : (g == 1 ? 12 : 13); return true; }
        u.pm = 8 * x + (w - 24); u.pn = 11; return true;
    }
    __device__ __forceinline__ void a_ready(const Unit&) const {}
    __device__ __forceinline__ void done(const Unit&) const {}
};
struct InOrderQ {
    int x, w;
    __device__ __forceinline__ bool next(int i, Unit& u) const {
        int f;
        if (w < 24) { if (i >= 3) return false; f = w + 24 * i; } else { if (i >= 1) return false; f = 72 + (w - 24); }
        u.pm = 8 * x + (f & 7); const int qt = f >> 3; u.pn = qt < 4 ? qt : qt + 1; return true;
    }
    __device__ __forceinline__ void a_ready(const Unit&) const {}
    __device__ __forceinline__ void done(const Unit&) const {}
};
struct HalfOrder {
    int x, w, half;
    __device__ __forceinline__ bool next(int i, Unit& u) const { if (i >= 1) return false; u.pm = 32 * half + 4 * x + (w & 3); u.pn = w >> 2; return true; }
    __device__ __forceinline__ void a_ready(const Unit&) const {}
    __device__ __forceinline__ void done(const Unit&) const {}
};
struct UkvOrder {
    int x, p, cached;
    __device__ __forceinline__ bool next(int i, Unit& u) const {
        if (cached) { if (i >= 1) return false; u.pm = 32 + (x - 4) * 9; u.pn = p; return true; }
        const int pm = 8 * x + p;
        if (i < 8) { u.pm = pm < 32 ? pm : 32 + ((pm - 32) >> 3) * 9 + 1 + ((pm - 32) & 7); u.pn = i; return true; }
        return false;
    }
    __device__ __forceinline__ void a_ready(const Unit&) const {}
    __device__ __forceinline__ void done(const Unit&) const {}
};


template <class Epi, class Sched, bool ALIGN_EPI = false, bool SP2 = false, bool FP8 = false, int SCL_W = 0x7F7F7F7F, int SCL_A = 0x7F7F7F7F>
__device__ __forceinline__ void gemm_phase(PG8_LAS unsigned char* lds, const Gemm g, const Sched& S, const Epi& E) {
    int tid = threadIdx.x; asm volatile("" : "+v"(tid));
    const int wid = __builtin_amdgcn_readfirstlane(tid >> 6), lane = tid & 63, wr = wid >> 2, wc = wid & 3, fr = lane & 15, fq = lane >> 4;
    const int K = g.K, nt = FP8 ? K / (2 * BK) : K / BK;
    int sclw_ = SCL_W, scla_ = SCL_A; asm volatile("" : "+v"(sclw_), "+v"(scla_));
    unsigned voffA[2], voffB[2];
#pragma unroll
    for (int i = 0; i < 2; ++i) { int R, C; stage_rc(tid * 16 + i * 8192, R, C); const int Rb = Epi::PERM ? ((R & ~31) + perm32(R & 31)) : R;
        voffA[i] = FP8 ? (unsigned)(R * K + 2 * C) : (unsigned)(R * K + C) * 2u; voffB[i] = FP8 ? (unsigned)(Rb * K + 2 * C) : (unsigned)(Rb * K + C) * 2u; }
    const size_t kstep = (size_t)(BK * 2);
    const size_t hstep = (size_t)HALF * K * (FP8 ? 1 : 2);
    const size_t tstep = 2 * hstep;
    const unsigned ldsw = (unsigned)wid * 1024u;
    const int aoff = FP8 ? lds_byte(wr * 64 + fr, 16 * (fq & 1)) + (fq >> 1) * 1024 : lds_byte(wr * 64 + fr, fq * 8), boff = FP8 ? lds_byte(wc * 32 + fr, 16 * (fq & 1)) + (fq >> 1) * 1024 : lds_byte(wc * 32 + fr, fq * 8);
    constexpr int KST = FP8 ? 16 : 1024;
#define PG8_SA(b, h) (((b) * 2 + (h)) * HTB)
#define PG8_SB(b, h) ((4 + (b) * 2 + (h)) * HTB)
#define PG8_STAGE(bufoff, gbase, voff) do { _Pragma("unroll") for (int _i = 0; _i < 2; ++_i) \
        __builtin_amdgcn_global_load_lds((const unsigned*)((const char*)(gbase) + (voff)[_i]), (PG8_LAS unsigned*)(lds + (bufoff) + ldsw + _i * 8192), 16, 0, 0); } while (0)
#define PG8_LDA(dst, b, h) do { _Pragma("unroll") for (int m = 0; m < 4; ++m) _Pragma("unroll") for (int k = 0; k < 2; ++k) dst[m][k] = *(const PG8_LAS bf16x8*)(lds + PG8_SA(b, h) + aoff + m * 2048 + k * KST); } while (0)
#define PG8_LDB(dst, b, h) do { _Pragma("unroll") for (int n = 0; n < 2; ++n) _Pragma("unroll") for (int k = 0; k < 2; ++k) dst[n][k] = *(const PG8_LAS bf16x8*)(lds + PG8_SB(b, h) + boff + n * 2048 + k * KST); } while (0)
#define PG8_CAT(x) __builtin_shufflevector(__builtin_bit_cast(pg8_i32x4, (x)[0]), __builtin_bit_cast(pg8_i32x4, (x)[1]), 0, 1, 2, 3, 4, 5, 6, 7)
#define PG8_MMA(ai, bj, At, Bt) do { __builtin_amdgcn_s_setprio(1); \
        if constexpr (FP8) { _Pragma("unroll") for (int m = 0; m < 4; ++m) _Pragma("unroll") for (int n = 0; n < 2; ++n) \
            asm volatile("v_mfma_scale_f32_16x16x128_f8f6f4 %0, %1, %2, %0, %3, %4 op_sel_hi:[0,0,0]" : "+v"(acc[ai][bj][m][n]) : "v"(PG8_CAT(Bt[n])), "v"(PG8_CAT(At[m])), "v"(sclw_), "v"(scla_)); } \
        else { _Pragma("unroll") for (int m = 0; m < 4; ++m) _Pragma("unroll") for (int n = 0; n < 2; ++n) _Pragma("unroll") for (int k = 0; k < 2; ++k) \
            acc[ai][bj][m][n] = __builtin_amdgcn_mfma_f32_16x16x32_bf16(Bt[n][k], At[m][k], acc[ai][bj][m][n], 0, 0, 0); } \
        __builtin_amdgcn_s_setprio(0); } while (0)
#define PG8_WAIT_V(n) asm volatile("s_waitcnt vmcnt(" #n ")" ::: "memory")
#define PG8_WAIT_L(n) asm volatile("s_waitcnt lgkmcnt(" #n ")" ::: "memory")
#define PG8_BAR __builtin_amdgcn_s_barrier()
#define PG8_SCHED __builtin_amdgcn_sched_barrier(0)
    Unit cur, nxt; int ui = 0;
    if (!S.next(0, cur)) return;
    f32x4 acc[2][2][4][2];
#pragma unroll
    for (int a = 0; a < 2; ++a)
#pragma unroll
        for (int b = 0; b < 2; ++b)
#pragma unroll
            for (int m = 0; m < 4; ++m)
#pragma unroll
                for (int n = 0; n < 2; ++n) acc[a][b][m][n] = (f32x4){0.f, 0.f, 0.f, 0.f};
    bf16x8 At[4][2], B0[2][2], B1[2][2];
    const char* cA = (const char*)g.A + (size_t)cur.pm * tstep; const char* cB = (const char*)g.Bt + (size_t)cur.pn * tstep;
    S.a_ready(cur);
    if constexpr (SP2) {
        PG8_STAGE(PG8_SB(0, 0), cB, voffB); PG8_STAGE(PG8_SB(0, 1), cB + hstep, voffB); PG8_STAGE(PG8_SA(0, 0), cA, voffA); PG8_STAGE(PG8_SA(0, 1), cA + hstep, voffA);
        if (wr == 1) PG8_BAR;
        PG8_WAIT_V(2); PG8_BAR;
        PG8_STAGE(PG8_SB(1, 0), cB + kstep, voffB); PG8_STAGE(PG8_SA(1, 0), cA + kstep, voffA); PG8_STAGE(PG8_SB(1, 1), cB + hstep + kstep, voffB);
        PG8_WAIT_V(6); PG8_BAR;
    } else {
        PG8_STAGE(PG8_SB(0, 0), cB, voffB); PG8_STAGE(PG8_SA(0, 0), cA, voffA); PG8_STAGE(PG8_SB(0, 1), cB + hstep, voffB); PG8_STAGE(PG8_SA(0, 1), cA + hstep, voffA);
        if (wr == 1) PG8_BAR;
        PG8_WAIT_V(4); PG8_BAR;
        PG8_STAGE(PG8_SB(1, 0), cB + kstep, voffB); PG8_STAGE(PG8_SA(1, 0), cA + kstep, voffA); PG8_STAGE(PG8_SB(1, 1), cB + hstep + kstep, voffB);
        PG8_WAIT_V(6); PG8_BAR;
    }
    for (;;) {
        const bool has_next = S.next(ui + 1, nxt);
        const char* nA = has_next ? (const char*)g.A + (size_t)nxt.pm * tstep : cA; const char* nB = has_next ? (const char*)g.Bt + (size_t)nxt.pn * tstep : cB;
        for (int t = 0; t < nt; t += 2) {
            const bool last = (t == nt - 2);
            const char* a1 = cA + (size_t)(t + 1) * kstep;
            const char* a2 = last ? nA : cA + (size_t)(t + 2) * kstep; const char* b2 = last ? nB : cB + (size_t)(t + 2) * kstep;
            const char* a3 = a2 + kstep; const char* b3 = b2 + kstep;
            if (last && has_next) S.a_ready(nxt);
            if constexpr (SP2) {
            PG8_LDB(B0, 0, 0); PG8_LDB(B1, 0, 1); PG8_SCHED; PG8_LDA(At, 0, 0); PG8_STAGE(PG8_SA(1, 1), a1 + hstep, voffA);
            PG8_WAIT_V(8); PG8_WAIT_L(0); PG8_BAR; PG8_MMA(0, 0, At, B0); PG8_MMA(0, 1, At, B1); PG8_BAR; PG8_SCHED;
            PG8_LDA(At, 0, 1); PG8_STAGE(PG8_SB(0, 0), b2, voffB); PG8_STAGE(PG8_SB(0, 1), b2 + hstep, voffB); PG8_STAGE(PG8_SA(0, 0), a2, voffA);
            PG8_WAIT_V(8); PG8_WAIT_L(0); PG8_BAR; PG8_MMA(1, 0, At, B0); PG8_MMA(1, 1, At, B1); PG8_BAR; PG8_SCHED;
            PG8_LDB(B0, 1, 0); PG8_LDB(B1, 1, 1); PG8_SCHED; PG8_LDA(At, 1, 0); PG8_STAGE(PG8_SA(0, 1), a2 + hstep, voffA);
            PG8_WAIT_V(8); PG8_WAIT_L(0); PG8_BAR; PG8_MMA(0, 0, At, B0); PG8_MMA(0, 1, At, B1); PG8_BAR; PG8_SCHED;
            PG8_LDA(At, 1, 1); PG8_STAGE(PG8_SB(1, 0), b3, voffB); PG8_STAGE(PG8_SB(1, 1), b3 + hstep, voffB); PG8_STAGE(PG8_SA(1, 0), a3, voffA);
            PG8_WAIT_V(8); PG8_WAIT_L(0); PG8_BAR; PG8_MMA(1, 0, At, B0); PG8_MMA(1, 1, At, B1); PG8_BAR; PG8_SCHED;
            } else {
            PG8_LDB(B0, 0, 0); PG8_SCHED; PG8_LDA(At, 0, 0); PG8_STAGE(PG8_SA(1, 1), a1 + hstep, voffA);
            PG8_WAIT_L(8); PG8_BAR; PG8_WAIT_L(0); PG8_MMA(0, 0, At, B0); PG8_BAR; PG8_SCHED;
            PG8_LDB(B1, 0, 1); PG8_STAGE(PG8_SB(0, 0), b2, voffB);
            PG8_BAR; PG8_WAIT_L(0); PG8_MMA(0, 1, At, B1); PG8_BAR;
            PG8_LDA(At, 0, 1); PG8_STAGE(PG8_SA(0, 0), a2, voffA);
            PG8_BAR; PG8_WAIT_L(0); PG8_MMA(1, 0, At, B0); PG8_BAR; PG8_SCHED;
            PG8_STAGE(PG8_SB(0, 1), b2 + hstep, voffB);
            PG8_WAIT_V(6); PG8_BAR; PG8_MMA(1, 1, At, B1); PG8_BAR;
            PG8_LDB(B0, 1, 0); PG8_SCHED; PG8_LDA(At, 1, 0); PG8_STAGE(PG8_SA(0, 1), a2 + hstep, voffA);
            PG8_WAIT_L(8); PG8_BAR; PG8_WAIT_L(0); PG8_MMA(0, 0, At, B0); PG8_BAR; PG8_SCHED;
            PG8_LDB(B1, 1, 1); PG8_STAGE(PG8_SB(1, 0), b3, voffB);
            PG8_BAR; PG8_WAIT_L(0); PG8_MMA(0, 1, At, B1); PG8_BAR;
            PG8_LDA(At, 1, 1); PG8_STAGE(PG8_SA(1, 0), a3, voffA);
            PG8_BAR; PG8_WAIT_L(0); PG8_MMA(1, 0, At, B0); PG8_BAR; PG8_SCHED;
            PG8_STAGE(PG8_SB(1, 1), b3 + hstep, voffB);
            PG8_WAIT_V(6); PG8_BAR; PG8_MMA(1, 1, At, B1); PG8_BAR;
            }
        }
        if constexpr (ALIGN_EPI) { if (wr == 0) PG8_BAR; }
        if constexpr (!Epi::AFTER_DRAIN) { E(acc, cur, wr, wc, fr, fq); S.done(cur); }
        if (!has_next) break;
#pragma unroll
        for (int a = 0; a < 2; ++a)
#pragma unroll
            for (int b = 0; b < 2; ++b)
#pragma unroll
                for (int m = 0; m < 4; ++m)
#pragma unroll
                    for (int n = 0; n < 2; ++n) acc[a][b][m][n] = (f32x4){0.f, 0.f, 0.f, 0.f};
        cur = nxt; cA = nA; cB = nB; ++ui;
        if constexpr (ALIGN_EPI) { if (wr == 1) PG8_BAR; }
    }
    PG8_WAIT_V(0);
    if constexpr (!ALIGN_EPI) { if (wr == 0) PG8_BAR; }
    PG8_BAR;
    if constexpr (Epi::AFTER_DRAIN) { E.fused(acc, cur, wr, wc, fr, fq, lds, wid, lane); S.done(cur); }
#undef PG8_SA
#undef PG8_SB
#undef PG8_STAGE
#undef PG8_LDA
#undef PG8_LDB
#undef PG8_MMA
#undef PG8_CAT
#undef PG8_WAIT_V
#undef PG8_WAIT_L
#undef PG8_BAR
#undef PG8_SCHED
}
}


namespace att {
#define ALAS __attribute__((address_space(3)))
typedef unsigned short bf16_t;
using bf16x8 = __attribute__((ext_vector_type(8))) short;
using s16x4  = __attribute__((ext_vector_type(4))) short;
using f32x16 = __attribute__((ext_vector_type(16))) float;
using u32x4  = __attribute__((ext_vector_type(4))) unsigned;
using i32x4  = __attribute__((ext_vector_type(4))) int;
using i32x8  = __attribute__((ext_vector_type(8))) int;
using i32x2  = __attribute__((ext_vector_type(2))) int;
constexpr int KVBLK = 64, QBLK = 32;
constexpr int SHM_V = KVBLK * 128, SHM_K = KVBLK * 128, SHM_KR = KVBLK * 64;
constexpr int NBUF = 3;
constexpr int ATT_LDS_BYTES = NBUF * SHM_V + NBUF * SHM_K + 2048 + NBUF * SHM_KR;
constexpr float THR = 5.f;
#define KSWZ8(row, colB) ((row) * 128 + ((colB) ^ ((((row) >> 1) & 7) << 4)))
#define VSWZ8(row, c16) ((row) * 128 + (((((c16) >> 1) ^ (((row) >> 1) & 3)) << 5) | (((c16) & 1) << 4)))
#define KSWZ4(row, colB) ((row) * 64 + ((colB) ^ ((((row) >> 2) & 3) << 4)))
#define SBAR() __builtin_amdgcn_sched_barrier(0)
__device__ __forceinline__ int crow(int r, int hi) { return (r & 3) + 8 * (r >> 2) + 4 * hi; }
__device__ __forceinline__ unsigned cvtpk(float lo, float hi) { unsigned r; asm volatile("v_cvt_pk_bf16_f32 %0, %1, %2" : "=v"(r) : "v"(lo), "v"(hi)); return r; }

__device__ __forceinline__ void partialSM(f32x16& p0, f32x16& p1, float& m_reg, float& mn, float& alpha, const float C, const float thrs) {
  float pmax = p0[0];
#pragma unroll
  for (int r = 1; r < 16; ++r) pmax = fmaxf(pmax, p0[r]);
#pragma unroll
  for (int r = 0; r < 16; ++r) pmax = fmaxf(pmax, p1[r]);
  { auto rr = __builtin_amdgcn_permlane32_swap(__float_as_uint(pmax), __float_as_uint(pmax), false, false);
    pmax = fmaxf(__uint_as_float(rr[0]), __uint_as_float(rr[1])); }
  if (__builtin_expect(__all(pmax - m_reg <= thrs), 1)) { mn = m_reg; alpha = 1.f; }
  else { mn = fmaxf(m_reg, pmax); alpha = __builtin_amdgcn_exp2f((m_reg - mn) * C); m_reg = mn; }
  float mnC = -mn * C;
#pragma unroll
  for (int r = 0; r < 16; ++r) p0[r] = fmaf(p0[r], C, mnC);
#pragma unroll
  for (int r = 0; r < 16; ++r) p1[r] = fmaf(p1[r], C, mnC);
#pragma unroll
  for (int r = 0; r < 16; ++r) p0[r] = __builtin_amdgcn_exp2f(p0[r]);
}
__device__ __forceinline__ int cvt4_fp8(float a, float b, float c, float d) { int w = __builtin_amdgcn_cvt_pk_fp8_f32(a, b, 0, false); return __builtin_amdgcn_cvt_pk_fp8_f32(c, d, w, true); }
__device__ __forceinline__ void finishSM(f32x16& p0, f32x16& p1, float alpha, float& l_reg, i32x8& pa) {
#pragma unroll
  for (int r = 0; r < 16; ++r) p1[r] = __builtin_amdgcn_exp2f(p1[r]);
  float ps = 0;
#pragma unroll
  for (int r = 0; r < 16; ++r) ps += p0[r];
#pragma unroll
  for (int r = 0; r < 16; ++r) ps += p1[r];
  { auto rr = __builtin_amdgcn_permlane32_swap(__float_as_uint(ps), __float_as_uint(ps), false, false);
    ps = __uint_as_float(rr[0]) + __uint_as_float(rr[1]); }
  l_reg = l_reg * alpha + ps;
#pragma unroll
  for (int j = 0; j < 4; ++j) { const unsigned d = (unsigned)cvt4_fp8(p0[4 * j], p0[4 * j + 1], p0[4 * j + 2], p0[4 * j + 3]), e = (unsigned)cvt4_fp8(p1[4 * j], p1[4 * j + 1], p1[4 * j + 2], p1[4 * j + 3]);
    auto rr = __builtin_amdgcn_permlane32_swap(d, e, false, false); pa[2 * j] = (int)rr[0]; pa[2 * j + 1] = (int)rr[1]; }
}
template <bool MLA>
__device__ __forceinline__ void qkt(f32x16& p0, f32x16& p1, const ALAS char* Ks, const ALAS char* Krs, const i32x8* q8, int r32, int hi, int scl) {
  p0 = f32x16{}; p1 = f32x16{};
#define LD32(base, off0, off1) ({ const i32x4 l_ = *reinterpret_cast<const ALAS i32x4*>((base) + (off0)), h_ = *reinterpret_cast<const ALAS i32x4*>((base) + (off1)); (i32x8){l_[0], l_[1], l_[2], l_[3], h_[0], h_[1], h_[2], h_[3]}; })
#pragma unroll
  for (int ks = 0; ks < 2; ++ks) { const int cb = ks * 64 + hi * 32;
    const i32x8 a0 = LD32(Ks, KSWZ8(r32, cb), KSWZ8(r32, cb + 16)), a1 = LD32(Ks, KSWZ8(32 + r32, cb), KSWZ8(32 + r32, cb + 16));
    p0 = __builtin_amdgcn_mfma_scale_f32_32x32x64_f8f6f4(a0, q8[ks], p0, 0, 0, 0, scl, 0, scl);
    p1 = __builtin_amdgcn_mfma_scale_f32_32x32x64_f8f6f4(a1, q8[ks], p1, 0, 0, 0, scl, 0, scl); }
  if constexpr (MLA) { const int cb = hi * 32;
    const i32x8 a0 = LD32(Krs, KSWZ4(r32, cb), KSWZ4(r32, cb + 16)), a1 = LD32(Krs, KSWZ4(32 + r32, cb), KSWZ4(32 + r32, cb + 16));
    p0 = __builtin_amdgcn_mfma_scale_f32_32x32x64_f8f6f4(a0, q8[2], p0, 0, 0, 0, scl, 0, scl);
    p1 = __builtin_amdgcn_mfma_scale_f32_32x32x64_f8f6f4(a1, q8[2], p1, 0, 0, 0, scl, 0, scl); }
#undef LD32
}
template <int OFF> __device__ __forceinline__ i32x2 tr_read8(int vb) {
  i32x2 r; asm volatile("ds_read_b64_tr_b8 %0, %1 offset:%2" : "=&v"(r) : "v"(vb), "i"(OFF) : "memory"); return r;
}
__device__ __forceinline__ int v8_rd_base(int lane, int d0) { const int i16 = lane & 15, q = i16 >> 1, p = i16 & 1, g = (lane >> 4) & 1, hi = lane >> 5;
  return (32 * hi + q) * 128 + ((d0 ^ ((q >> 1) & 3)) << 5) + 16 * g + 8 * p; }
template <int BUF_OFF> __device__ __forceinline__ void pv_one(f32x16& od, int vb, const i32x8& pa, int scl) {
  const i32x2 t0 = tr_read8<BUF_OFF>(vb), t1 = tr_read8<BUF_OFF + 1024>(vb), t2 = tr_read8<BUF_OFF + 2048>(vb), t3 = tr_read8<BUF_OFF + 3072>(vb);
  asm volatile("s_waitcnt lgkmcnt(0)" ::: "memory"); SBAR();
  const i32x8 b = (i32x8){t0[0], t0[1], t1[0], t1[1], t2[0], t2[1], t3[0], t3[1]};
  od = __builtin_amdgcn_mfma_scale_f32_32x32x64_f8f6f4(pa, b, od, 0, 0, 0, scl, 0, scl);
}
template <int BUF_OFF> __device__ __forceinline__ void pv_d0(f32x16* o, const int (&vb)[4], const i32x8& pa, int scl) {
  pv_one<BUF_OFF>(o[0], vb[0], pa, scl); pv_one<BUF_OFF>(o[1], vb[1], pa, scl); pv_one<BUF_OFF>(o[2], vb[2], pa, scl); pv_one<BUF_OFF>(o[3], vb[3], pa, scl);
}

template <bool MLA, int LDK, int SDEPTH>
__device__ __forceinline__ void attn_unit(const unsigned char* __restrict__ Qn, const unsigned char* __restrict__ Qr, const unsigned char* __restrict__ Kn, const unsigned char* __restrict__ Kr,
                                          const unsigned char* __restrict__ Vh, bf16_t* __restrict__ Ob, unsigned char* __restrict__ Ob8, bool o8, int seq, ALAS char* lds) {
  constexpr int NQ = MLA ? 3 : 2, LDQN = 1024, LDQR = 512, LDO = 2048;
  constexpr float SCALE = MLA ? 0.07216878364870323f : 0.08838834764831845f;
  constexpr float C = SCALE * 1.4426950408889634f, THRS = THR / SCALE;
  int tid = threadIdx.x; asm volatile("" : "+v"(tid));
  const int wid = tid >> 6, lane = tid & 63, r32 = lane & 31, hi = lane >> 5;
  int scl = 0x7F7F7F7F; asm volatile("" : "+v"(scl));
  ALAS char* V_lds = lds; ALAS char* K_lds = lds + NBUF * SHM_V; ALAS char* KR_lds = lds + NBUF * SHM_V + NBUF * SHM_K + 2048;
  ALAS float* wsf = (ALAS float*)(lds + NBUF * SHM_V + NBUF * SHM_K) + wid * 64; ALAS float* li_l = wsf; ALAS float* al_l = wsf + 32;
  float m_reg = -1e30f, l_reg = 0; f32x16 o[4] = {}; i32x8 qr[NQ];
  { const unsigned char* Qw = Qn + (long)(wid * QBLK + r32) * LDQN + hi * 32;
#pragma unroll
    for (int ks = 0; ks < 2; ++ks) { const i32x4 l_ = *reinterpret_cast<const i32x4*>(Qw + ks * 64), h_ = *reinterpret_cast<const i32x4*>(Qw + ks * 64 + 16);
      qr[ks] = (i32x8){l_[0], l_[1], l_[2], l_[3], h_[0], h_[1], h_[2], h_[3]}; }
    if constexpr (MLA) { const unsigned char* Qw2 = Qr + (long)(wid * QBLK + r32) * LDQR + hi * 32;
      const i32x4 l_ = *reinterpret_cast<const i32x4*>(Qw2), h_ = *reinterpret_cast<const i32x4*>(Qw2 + 16);
      qr[2] = (i32x8){l_[0], l_[1], l_[2], l_[3], h_[0], h_[1], h_[2], h_[3]}; } }
  const int kr8 = tid >> 3, kc8 = (tid & 7) * 16;
  const int rr4 = (tid >> 2) & 63, rc4 = (tid & 3) * 16; const bool rope_thr = tid < 256;
  const int vl = (int)(uintptr_t)V_lds; const int vb0[4] = {vl + v8_rd_base(lane, 0), vl + v8_rd_base(lane, 1), vl + v8_rd_base(lane, 2), vl + v8_rd_base(lane, 3)};
  struct { i32x4 vs, ks, kr; } sr_[SDEPTH];
#define SLOAD(i, k0) do { sr_[i].vs = *reinterpret_cast<const i32x4*>(&Vh[(long)((k0) + kr8) * LDK + kc8]); sr_[i].ks = *reinterpret_cast<const i32x4*>(&Kn[(long)((k0) + kr8) * LDK + kc8]); \
    if constexpr (MLA) { if (rope_thr) sr_[i].kr = *reinterpret_cast<const i32x4*>(&Kr[(long)((k0) + rr4) * 64 + rc4]); } } while (0)
#define SWRITE(b, i) do { *(ALAS i32x4*)(V_lds + (b) * SHM_V + VSWZ8(kr8, (tid & 7))) = sr_[i].vs; *(ALAS i32x4*)(K_lds + (b) * SHM_K + KSWZ8(kr8, kc8)) = sr_[i].ks; \
    if constexpr (MLA) { if (rope_thr) *(ALAS i32x4*)(KR_lds + (b) * SHM_KR + KSWZ4(rr4, rc4)) = sr_[i].kr; } } while (0)
#define SWAIT() do { if constexpr (SDEPTH == 1) asm volatile("s_waitcnt vmcnt(0)" ::: "memory"); else asm volatile("s_waitcnt vmcnt(2)" ::: "memory"); } while (0)
#define RESC(a) do { if (__any((a) < 1.f)) { if (hi == 0) al_l[r32] = (a); asm volatile("s_waitcnt lgkmcnt(0)" ::: "memory"); \
    _Pragma("unroll") for (int d = 0; d < 4; ++d) _Pragma("unroll") for (int r = 0; r < 16; ++r) o[d][r] *= al_l[crow(r, hi)]; } } while (0)
  f32x16 pA0, pA1, pB0, pB1; float mnA, mnB, alA, alB; i32x8 pa; const int NT = seq / KVBLK;
  constexpr int SE = 0, SO = SDEPTH - 1;
  SLOAD(SE, 0); asm volatile("s_waitcnt vmcnt(0)" ::: "memory"); SWRITE(0, SE); __syncthreads();
  qkt<MLA>(pA0, pA1, K_lds, KR_lds, qr, r32, hi, scl); partialSM(pA0, pA1, m_reg, mnA, alA, C, THRS);
  SLOAD(SO, KVBLK); if constexpr (SDEPTH == 2) { if (2 < NT) SLOAD(SE, 2 * KVBLK); }
  SWAIT(); SWRITE(1, SO); __syncthreads();
  int kb = 1;
#define VBX(b) const int vbx[4] = {vb0[0] + (b) * SHM_V, vb0[1] + (b) * SHM_V, vb0[2] + (b) * SHM_V, vb0[3] + (b) * SHM_V}
  for (int j = 1; j + 1 < NT; j += 2) {
    { const int vbi = kb == 0 ? 2 : kb - 1, wbi = kb == 2 ? 0 : kb + 1; VBX(vbi);
      SBAR(); qkt<MLA>(pB0, pB1, K_lds + kb * SHM_K, KR_lds + kb * SHM_KR, qr, r32, hi, scl);
      finishSM(pA0, pA1, alA, l_reg, pa); SBAR();
      SLOAD(SO, (j + SDEPTH) * KVBLK); SBAR();
      pv_d0<0>(o, vbx, pa, scl); partialSM(pB0, pB1, m_reg, mnB, alB, C, THRS);
      SWAIT(); SWRITE(wbi, SE);
      RESC(alB); __syncthreads(); kb = wbi; }
    { const int vbi = kb == 0 ? 2 : kb - 1, wbi = kb == 2 ? 0 : kb + 1; VBX(vbi);
      SBAR(); qkt<MLA>(pA0, pA1, K_lds + kb * SHM_K, KR_lds + kb * SHM_KR, qr, r32, hi, scl);
      finishSM(pB0, pB1, alB, l_reg, pa); SBAR();
      if (SDEPTH == 1 || j + 3 < NT) SLOAD(SE, (j + 1 + SDEPTH) * KVBLK); SBAR();
      pv_d0<0>(o, vbx, pa, scl); partialSM(pA0, pA1, m_reg, mnA, alA, C, THRS);
      SWAIT(); SWRITE(wbi, SO);
      RESC(alA); __syncthreads(); kb = wbi; }
  }
  { const int vbi = kb == 0 ? 2 : kb - 1; VBX(vbi);
    SBAR(); qkt<MLA>(pB0, pB1, K_lds + kb * SHM_K, KR_lds + kb * SHM_KR, qr, r32, hi, scl);
    finishSM(pA0, pA1, alA, l_reg, pa); SBAR();
    pv_d0<0>(o, vbx, pa, scl); partialSM(pB0, pB1, m_reg, mnB, alB, C, THRS); }
  __syncthreads(); RESC(alB);
  finishSM(pB0, pB1, alB, l_reg, pa); SBAR();
  { VBX(kb); pv_d0<0>(o, vbx, pa, scl); }
#undef VBX
  if (hi == 0) li_l[r32] = l_reg; asm volatile("s_waitcnt lgkmcnt(0)" ::: "memory");
  float rli[16];
#pragma unroll
  for (int r = 0; r < 16; ++r) rli[r] = __builtin_amdgcn_rcpf(li_l[crow(r, hi)]);
  bf16_t* Ow = Ob + (long)(wid * QBLK) * LDO; unsigned char* Ow8 = Ob8 + (long)(wid * QBLK) * LDO;
#pragma unroll
  for (int r = 0; r < 16; r += 2) {
#pragma unroll
    for (int d0 = 0; d0 < 4; ++d0) {
      const float a = o[d0][r] * rli[r], b = o[d0][r + 1] * rli[r + 1];
      const float send = (lane & 1) ? a : b;
      const float recv = __uint_as_float((unsigned)__builtin_amdgcn_mov_dpp((int)__float_as_uint(send), 0xB1, 0xF, 0xF, true));
      const float lo_ = (lane & 1) ? recv : a, hi_ = (lane & 1) ? b : recv;
      const int orow = crow(r + (lane & 1), hi);
      if (o8) *reinterpret_cast<unsigned short*>(Ow8 + (long)orow * LDO + d0 * 32 + (r32 & ~1)) = (unsigned short)__builtin_amdgcn_cvt_pk_fp8_f32(16.0f * lo_, 16.0f * hi_, 0, false);
      else *reinterpret_cast<unsigned*>(Ow + (long)orow * LDO + d0 * 32 + (r32 & ~1)) = cvtpk(lo_, hi_);
    }
  }
  __syncthreads();
#undef SLOAD
#undef SWRITE
#undef SWAIT
#undef RESC
}
}


constexpr int NWAVES = 8;
constexpr int DM = 2048, NCTX = 8192, NLAT = 8192, MTOK = NCTX + NLAT, DEPTH = 4, NGRP = 5;
constexpr int IN_COLS = 3392, INP = 3584, DFF = 5632, NGU = 2 * DFF, KROWS = NCTX + 4 * 2304, MODW = 6 * DM;
constexpr int KCH = 32;
constexpr size_t OUT_Y = 0, OUT_KA = 33554432, OUT_VA = 41943040, OUT_CKV = 50331648, OUT_KR = 58720256, OUT_TOTAL = 60817408;
constexpr size_t MiB = 1u << 20;
constexpr size_t WS_CTL = 0, CTL_ZERO_BYTES = 1 * MiB;
constexpr size_t WS_MOD = 1 * MiB;
constexpr size_t WS_PART = 2 * MiB;
constexpr size_t WS_WIN = 32 * MiB, SZ_WIN = 14 * MiB;
constexpr size_t WS_WO = 88 * MiB, SZ_WO = 8 * MiB;
constexpr size_t WS_WGU = 120 * MiB, SZ_WGU = 44 * MiB;
constexpr size_t WS_WD = 296 * MiB, SZ_WD = 22 * MiB;
constexpr size_t WS_WUKV = 384 * MiB, SZ_WUKV = 1 * MiB;
constexpr size_t WS_X = 388 * MiB;
constexpr size_t WS_XN = 516 * MiB;
constexpr size_t WS_H = 580 * MiB;
constexpr size_t WS_QA = 756 * MiB, WS_QBN = 788 * MiB, WS_QBR = 820 * MiB, WS_O = 836 * MiB;
constexpr size_t WS_KA = 900 * MiB, SZ_KA = 9 * MiB, WS_VA = 936 * MiB, WS_CKV = 972 * MiB;
constexpr size_t WS_KR = 1008 * MiB, SZ_KR = 3 * MiB;
constexpr size_t WS_KBN = 1020 * MiB, WS_VB = 1054 * MiB;
constexpr size_t WS_WIN8 = 1088 * MiB, SZ_WIN8 = 7 * MiB;
constexpr size_t WS_WO8 = 1148 * MiB, SZ_WO8 = 4 * MiB;
constexpr size_t WS_XN8 = 1116 * MiB, WS_END = 1164 * MiB;
static_assert((size_t)KROWS * 256 * 2 <= SZ_KA && (size_t)KROWS * 64 * 2 <= SZ_KR && (size_t)KROWS * 1024 * 2 <= WS_VB - WS_KBN && (size_t)KCH * 4 * 5 * 12288 * 4 <= WS_WIN - WS_PART, "ws map");
constexpr int CW_BAR = 4096;
constexpr int RING_OFF = 0, RING_BYTES = 131072;
constexpr int XS_OFF = RING_BYTES;
constexpr int MISC_OFF = XS_OFF + 8192;
constexpr int PT_OFF = MISC_OFF + 256;
constexpr int LDS_BYTES = 147456;
static_assert(MISC_OFF + 128 <= LDS_BYTES && att::ATT_LDS_BYTES <= RING_BYTES, "LDS map");

#define GAS __attribute__((address_space(1)))
#define LAS __attribute__((address_space(3)))
typedef unsigned short bf16;
typedef unsigned v4u __attribute__((ext_vector_type(4)));
typedef unsigned v2u __attribute__((ext_vector_type(2)));
typedef float f32x4 __attribute__((ext_vector_type(4)));
#define LDS_WAIT() asm volatile("s_waitcnt lgkmcnt(0)" ::: "memory")
__device__ __forceinline__ unsigned pk2(float lo, float hi) { return pg8::cvt_pk_bf16(lo, hi); }
__device__ __forceinline__ float shx(float v, int lane, int m) { return __int_as_float(__builtin_amdgcn_ds_bpermute((lane ^ m) << 2, __float_as_int(v))); }
__device__ __forceinline__ float wave_sum(float v, int lane) {
#pragma unroll
    for (int o = 1; o < 64; o <<= 1) v += shx(v, lane, o);
    return v;
}
__device__ __forceinline__ float silu_f(float x) { return x / (1.0f + __expf(-x)); }

#define XB_TMO      128
#define XB_XCNT(j)  (256  + 64 * (j))
#define XB_XSUB(j)  (1280 + 64 * (j))
#define XB_XGEN(j)  (2304 + 64 * (j))
#define XB_TOP      3328
#define XB_TOPGEN   3392
#define XCD_BAR_WORDS 3456
#define XB_SPIN_CAP (1u << 18)

__device__ __forceinline__ unsigned xb_ld(unsigned* p)              { return __hip_atomic_load(p, __ATOMIC_RELAXED, __HIP_MEMORY_SCOPE_AGENT); }
__device__ __forceinline__ unsigned xb_add(unsigned* p, unsigned v) { return __hip_atomic_fetch_add(p, v, __ATOMIC_RELAXED, __HIP_MEMORY_SCOPE_AGENT); }
__device__ __forceinline__ unsigned xb_xcc_id() { return (unsigned)__builtin_amdgcn_s_getreg((3 << 11) | 20) & 0xFu; }
#define XB_SPIN(cond, bar) do { unsigned _sp = 0; while (cond) { __builtin_amdgcn_s_sleep(1); \
    if ((++_sp & 255u) == 0u) { if (xb_ld(&(bar)[XB_TMO])) break; if (_sp > XB_SPIN_CAP) { atomicAdd(&(bar)[XB_TMO], 1u); break; } } } } while (0)

__device__ __forceinline__ int xb_tid() { int t = threadIdx.x; asm volatile("" : "+v"(t)); return t; }
struct XcdBarrier {
    unsigned* bar; unsigned x;
    volatile LAS unsigned* st;
};

__device__ __forceinline__ XcdBarrier xcd_barrier_post(unsigned* bar, volatile LAS unsigned* st) {
    XcdBarrier b; b.bar = bar; b.x = xb_xcc_id(); b.st = st;
    if (xb_tid() == 0) (void)xb_add(&bar[XB_XCNT(b.x)], 1u);
    return b;
}
__device__ __forceinline__ void xcd_barrier_complete(unsigned* bar, unsigned x, unsigned& nloc, unsigned& nx) {
    const unsigned G = gridDim.x * gridDim.y * gridDim.z;
    unsigned sum, cnt, mine, sp = 0u;
    for (;;) {
        sum = 0u; cnt = 0u; mine = 0u;
#pragma unroll
        for (unsigned j = 0; j < 16; ++j) { const unsigned c = xb_ld(&bar[XB_XCNT(j)]); sum += c; cnt += (c > 0u) ? 1u : 0u; mine = (j == x) ? c : mine; }
        if (sum == G) break;
        __builtin_amdgcn_s_sleep(1);
        if ((++sp & 255u) == 0u) { if (xb_ld(&bar[XB_TMO])) break; if (sp > XB_SPIN_CAP) { atomicAdd(&bar[XB_TMO], 1u); break; } }
    }
    nloc = mine > 0u ? mine : 1u; nx = cnt > 0u ? cnt : 1u;
}

__device__ __forceinline__ void xcd_barrier(const XcdBarrier& b) {
    asm volatile("s_waitcnt vmcnt(0)" ::: "memory");
    __syncthreads();
    if (xb_tid() == 0) {
        unsigned* bar = b.bar;
        __builtin_amdgcn_s_waitcnt(0);
        unsigned nloc = b.st[0], nx = b.st[1];
        if (nloc == 0u) { xcd_barrier_complete(bar, b.x, nloc, nx); b.st[0] = nloc; b.st[1] = nx; }
        const unsigned old = xb_add(&bar[XB_XSUB(b.x)], 1u);
        const unsigned gen = old / nloc;
        if (old + 1u == (gen + 1u) * nloc) {
            __builtin_amdgcn_fence(__ATOMIC_RELEASE, "agent");
            asm volatile("s_waitcnt vmcnt(0)" ::: "memory");
            const unsigned og = xb_add(&bar[XB_TOP], 1u);
            const unsigned tg = og / nx;
            if (og + 1u == (tg + 1u) * nx) xb_add(&bar[XB_TOPGEN], 1u);
            else XB_SPIN(xb_ld(&bar[XB_TOPGEN]) == tg, bar);
            __builtin_amdgcn_fence(__ATOMIC_ACQUIRE, "agent");
            xb_add(&bar[XB_XGEN(b.x)], 1u);
            asm volatile("s_waitcnt vmcnt(0)" ::: "memory");
        } else {
            XB_SPIN(xb_ld(&bar[XB_XGEN(b.x)]) == gen, bar);
            __builtin_amdgcn_fence(__ATOMIC_ACQUIRE, "agent");
            asm volatile("s_waitcnt vmcnt(0)" ::: "memory");
        }
    }
    __syncthreads();
}


struct Args { const float* in[23]; float* out; unsigned char* ws; int ph_lo, ph_hi; };
enum { I_XP = 0, I_XS, I_CKA, I_CVA, I_CCKV, I_CKR, I_C, I_CCTX, I_WADA, I_BADA, I_NATT, I_NFFN, I_WIN, I_QN, I_KN, I_KVN, I_WUK, I_WUV, I_WO, I_WG, I_WU, I_WD, I_NF };
struct Frame {
    LAS unsigned char* lds;
    int wave, vcu, G;
    GAS unsigned char* ws;
};
template <int I> __device__ __forceinline__ const float* pin_() {
    const unsigned long long kp = (unsigned long long)__builtin_amdgcn_kernarg_segment_ptr();
    unsigned long long v;
    asm volatile("s_load_dwordx2 %0, %1, %2\n\ts_waitcnt lgkmcnt(0)" : "=s"(v) : "s"(kp), "i"(I * 8));
    return (const float*)(const GAS float*)v;
}
#define pin(F, I) pin_<(I)>()
__device__ __forceinline__ Frame fresh(const Frame& F) {
    Frame P = F;
    asm volatile("" : "+s"(P.ws), "+s"(P.lds), "+s"(P.vcu), "+s"(P.wave), "+s"(P.G));
    return P;
}
__device__ __forceinline__ int opaque_tid() { int t = threadIdx.x; asm volatile("" : "+v"(t)); return t; }


namespace pg8 {
__device__ __forceinline__ u32x2 pk8_fp8(float a0, float a1, float a2, float a3, float a4, float a5, float a6, float a7) {
    int lo = __builtin_amdgcn_cvt_pk_fp8_f32(a0, a1, 0, false); lo = __builtin_amdgcn_cvt_pk_fp8_f32(a2, a3, lo, true);
    int hi = __builtin_amdgcn_cvt_pk_fp8_f32(a4, a5, 0, false); hi = __builtin_amdgcn_cvt_pk_fp8_f32(a6, a7, hi, true);
    return (u32x2){(unsigned)lo, (unsigned)hi};
}
struct EpiIn {
    static constexpr bool PERM = true, AFTER_DRAIN = false;
    LAS unsigned char* lds; GAS unsigned char* ws; int l, pn_base;
    __device__ __forceinline__ void operator()(const f32x4 (&acc)[2][2][4][2], const Unit& u, int wr, int wc, int fr, int fq) const {
        { int t_ = threadIdx.x; asm volatile("" : "+v"(t_)); fr = t_ & 15; fq = (t_ >> 4) & 3; }
        const int pn = u.pn + pn_base, pm = u.pm;
        PG8_LAS float* xs = (PG8_LAS float*)(lds + XS_OFF);
        float* const outp = (float*)pin(F, 23);
        const bool lat = pm >= 32;
        const int lb = lat ? ((pm - 32) >> 3) : 0;
        const int kadd = lat ? 256 * (lb + 1) : 0;
        const int rbase = pm * BM + wr * 64 + fr;
        const int tb = lat ? (((pm - 32) & 7) * 256 + wr * 64) : (wr * 64);
        const float EPS = 1e-6f;
        float rstd[2][4][2];
        if (pn <= 4 || pn == 11) {
#pragma unroll
            for (int ai = 0; ai < 2; ++ai)
#pragma unroll
                for (int m = 0; m < 4; ++m)
#pragma unroll
                    for (int bj = 0; bj < 2; ++bj) { const f32x4 a = acc[ai][bj][m][0], b = acc[ai][bj][m][1];
                        float s = (a[0] * a[0] + a[1] * a[1]) + (a[2] * a[2] + a[3] * a[3]) + (b[0] * b[0] + b[1] * b[1]) + (b[2] * b[2] + b[3] * b[3]);
                        s += shx(s, fr + 16 * fq, 16); s += shx(s, fr + 16 * fq, 32);
                        if (fq == 0) xs[(ai * HALF + wr * 64 + m * 16 + fr) * 8 + bj * 4 + wc] = s; }
            asm volatile("s_waitcnt lgkmcnt(0)" ::: "memory"); __builtin_amdgcn_s_barrier(); asm volatile("" ::: "memory");
#pragma unroll
            for (int ai = 0; ai < 2; ++ai)
#pragma unroll
                for (int m = 0; m < 4; ++m) { const PG8_LAS f32x4* p = (const PG8_LAS f32x4*)(xs + (ai * HALF + wr * 64 + m * 16 + fr) * 8);
                    const f32x4 a = p[0], b = p[1]; const float s0 = (a[0] + a[1]) + (a[2] + a[3]), s1 = (b[0] + b[1]) + (b[2] + b[3]);
                    if (pn == 11) { const float r = __builtin_amdgcn_rsqf((s0 + s1) * (1.0f / 256.0f) + EPS); rstd[ai][m][0] = r; rstd[ai][m][1] = r; }
                    else { rstd[ai][m][0] = __builtin_amdgcn_rsqf(s0 * (1.0f / 128.0f) + EPS); rstd[ai][m][1] = __builtin_amdgcn_rsqf(s1 * (1.0f / 128.0f) + EPS); } }
        }
        const int p0 = 32 * wc + 8 * fq;
        if (pn <= 4) {
            const float* nw = ((pn == 4) ? pin(F, I_KN) : pin(F, I_QN)) + l * 128;
            float w[2][4], invf[2][2];
#pragma unroll
            for (int n = 0; n < 2; ++n)
#pragma unroll
                for (int e = 0; e < 4; ++e) { const int p = p0 + 4 * n + e; w[n][e] = nw[(p >> 1) + 64 * (p & 1)]; }
#pragma unroll
            for (int n = 0; n < 2; ++n)
#pragma unroll
                for (int eh = 0; eh < 2; ++eh) { const int f = (16 * wc + 4 * fq + 2 * n + eh) & 31; invf[n][eh] = __builtin_amdgcn_exp2f((float)f * (-13.287712379549449f / 32.0f)) * 0.15915494309189535f; }
#pragma unroll
            for (int ai = 0; ai < 2; ++ai)
#pragma unroll
                for (int m = 0; m < 4; ++m) {
                    const int r = rbase + ai * HALF + m * 16, t = tb + ai * HALF + m * 16 + fr;
                    const float pos = (float)((wc < 2) ? (t >> 6) : (t & 63));
#pragma unroll
                    for (int bj = 0; bj < 2; ++bj) {
                        float v[2][4]; const float rs = rstd[ai][m][bj];
#pragma unroll
                        for (int n = 0; n < 2; ++n)
#pragma unroll
                            for (int e = 0; e < 4; ++e) v[n][e] = acc[ai][bj][m][n][e] * rs * w[n][e];
                        if (lat) {
#pragma unroll
                            for (int n = 0; n < 2; ++n)
#pragma unroll
                                for (int eh = 0; eh < 2; ++eh) { const float rev = pos * invf[n][eh]; const float c = __builtin_amdgcn_cosf(rev), s = __builtin_amdgcn_sinf(rev);
                                    const float x1 = v[n][2 * eh], x2 = v[n][2 * eh + 1]; v[n][2 * eh] = x1 * c - x2 * s; v[n][2 * eh + 1] = x2 * c + x1 * s; }
                        } else if (pn == 4) {
                            float* o = outp + OUT_KA + (size_t)((pm * 4 + l) * 256 + t) * 256 + bj * HALF + 16 * wc + 4 * fq;
                            *(f32x4*)o = (f32x4){v[0][0], v[0][2], v[1][0], v[1][2]}; *(f32x4*)(o + 64) = (f32x4){v[0][1], v[0][3], v[1][1], v[1][3]};
                        }
                        const u32x2 pk = pk8_fp8(v[0][0], v[0][1], v[0][2], v[0][3], v[1][0], v[1][1], v[1][2], v[1][3]);
                        if (pn == 4) *(u32x2*)((GAS unsigned char*)(ws + WS_KA + (size_t)l * SZ_KA) + (size_t)(r + kadd) * 256 + bj * HALF + p0) = pk;
                        else *(u32x2*)((GAS unsigned char*)(ws + WS_QA) + (size_t)r * 1024 + (2 * pn + bj) * HALF + p0) = pk;
                    }
                }
        } else if (pn == 12 || (pn >= 5 && pn <= 8)) {
#pragma unroll
            for (int ai = 0; ai < 2; ++ai)
#pragma unroll
                for (int m = 0; m < 4; ++m) {
                    const int r = rbase + ai * HALF + m * 16, t = tb + ai * HALF + m * 16 + fr;
#pragma unroll
                    for (int bj = 0; bj < 2; ++bj) { const f32x4 v0 = acc[ai][bj][m][0], v1 = acc[ai][bj][m][1];
                        if (pn == 12) { *(u32x2*)((GAS unsigned char*)(ws + WS_VA + (size_t)l * SZ_KA) + (size_t)(r + kadd) * 256 + bj * HALF + p0) = pk8_fp8(v0[0], v0[1], v0[2], v0[3], v1[0], v1[1], v1[2], v1[3]);
                            if (!lat) { float* o = outp + OUT_VA + (size_t)((pm * 4 + l) * 256 + t) * 256 + bj * HALF + p0; *(f32x4*)o = v0; *(f32x4*)(o + 4) = v1; } }
                        else *(u32x2*)((GAS unsigned char*)(ws + WS_QBN) + (size_t)r * 1024 + (pn - 5) * 256 + bj * HALF + p0) = pk8_fp8(v0[0], v0[1], v0[2], v0[3], v1[0], v1[1], v1[2], v1[3]); }
                }
        } else if (pn == 9 || pn == 10 || pn == 13) {
            float invf[2][2];
#pragma unroll
            for (int n = 0; n < 2; ++n)
#pragma unroll
                for (int eh = 0; eh < 2; ++eh) { const int f = (4 * fq + 2 * n + eh) & 15; invf[n][eh] = __builtin_amdgcn_exp2f((float)f * (-13.287712379549449f / 16.0f)) * 0.15915494309189535f; }
#pragma unroll
            for (int ai = 0; ai < 2; ++ai)
#pragma unroll
                for (int m = 0; m < 4; ++m) {
                    const int r = rbase + ai * HALF + m * 16, t = tb + ai * HALF + m * 16 + fr;
                    const float pos = (float)(((wc & 1) == 0) ? (t >> 6) : (t & 63));
#pragma unroll
                    for (int bj = 0; bj < 2; ++bj) {
                        if (pn == 13 && (bj == 1 || wc >= 2)) continue;
                        float v[2][4];
#pragma unroll
                        for (int n = 0; n < 2; ++n)
#pragma unroll
                            for (int e = 0; e < 4; ++e) v[n][e] = acc[ai][bj][m][n][e];
                        if (lat) {
#pragma unroll
                            for (int n = 0; n < 2; ++n)
#pragma unroll
                                for (int eh = 0; eh < 2; ++eh) { const float rev = pos * invf[n][eh]; const float c = __builtin_amdgcn_cosf(rev), s = __builtin_amdgcn_sinf(rev);
                                    const float x1 = v[n][2 * eh], x2 = v[n][2 * eh + 1]; v[n][2 * eh] = x1 * c - x2 * s; v[n][2 * eh + 1] = x2 * c + x1 * s; }
                        } else if (pn == 13) {
                            float* o = outp + OUT_KR + (size_t)((pm * 4 + l) * 256 + t) * 64 + 16 * wc + 4 * fq;
                            *(f32x4*)o = (f32x4){v[0][0], v[0][2], v[1][0], v[1][2]}; *(f32x4*)(o + 32) = (f32x4){v[0][1], v[0][3], v[1][1], v[1][3]};
                        }
                        const u32x2 pk = pk8_fp8(v[0][0], v[0][1], v[0][2], v[0][3], v[1][0], v[1][1], v[1][2], v[1][3]);
                        if (pn == 13) *(u32x2*)((GAS unsigned char*)(ws + WS_KR + (size_t)l * SZ_KR) + (size_t)(r + kadd) * 64 + p0) = pk;
                        else *(u32x2*)((GAS unsigned char*)(ws + WS_QBR) + (size_t)r * 512 + (pn - 9) * 256 + bj * HALF + p0) = pk;
                    }
                }
        } else {
            f32x4 w[2][2];
#pragma unroll
            for (int bj = 0; bj < 2; ++bj)
#pragma unroll
                for (int n = 0; n < 2; ++n) w[bj][n] = *(const f32x4*)(pin(F, I_KVN) + l * 256 + bj * HALF + p0 + 4 * n);
#pragma unroll
            for (int ai = 0; ai < 2; ++ai)
#pragma unroll
                for (int m = 0; m < 4; ++m) {
                    const int r = rbase + ai * HALF + m * 16, t = tb + ai * HALF + m * 16 + fr;
#pragma unroll
                    for (int bj = 0; bj < 2; ++bj) { const float rs = rstd[ai][m][bj]; const f32x4 v0 = acc[ai][bj][m][0] * rs * w[bj][0], v1 = acc[ai][bj][m][1] * rs * w[bj][1];
                        u32x4 pk; pk.x = cvt_pk_bf16(v0[0], v0[1]); pk.y = cvt_pk_bf16(v0[2], v0[3]); pk.z = cvt_pk_bf16(v1[0], v1[1]); pk.w = cvt_pk_bf16(v1[2], v1[3]);
                        *(u32x4*)((bf16_t*)(ws + WS_CKV + (size_t)l * SZ_KA) + (size_t)(r + kadd) * 256 + bj * HALF + p0) = pk;
                        if (!lat) { float* o = outp + OUT_CKV + (size_t)((pm * 4 + l) * 256 + t) * 256 + bj * HALF + p0; *(f32x4*)o = v0; *(f32x4*)(o + 4) = v1; } }
                }
        }
    }
};
}

__device__ __forceinline__ int win_dest(int o) {
    if (o < 1280) { const int d = o & 127; return (o & ~127) + ((d < 64) ? 2 * d : 2 * (d - 64) + 1); }
    if (o < 1536) return 3072 + (o - 1280);
    if (o < 3072) { const int h = (o - 1536) / 192, j = (o - 1536) % 192;
        if (j < 128) return 1280 + h * 128 + j;
        const int i = j - 128; return 2304 + h * 64 + ((i < 32) ? 2 * i : 2 * (i - 32) + 1); }
    if (o < 3328) return 2816 + (o - 3072);
    { const int i = o - 3328; return 3328 + ((i < 32) ? 2 * i : 2 * (i - 32) + 1); }
}
template <int KIND> __device__ __forceinline__ int dest_row(int n, int row_off) {
    if (KIND == 1) return win_dest(n);
    if (KIND == 2) return ((n >> 7) << 8) + (n & 127);
    if (KIND == 3) return ((n >> 7) << 8) + 128 + (n & 127);
    return n + row_off;
}
template <int KIND>
__device__ __forceinline__ void p0_transpose_item(const float* W, int K, int N, bf16* WT, int row_off, LAS float* scr, int item, int lane) {
    const int nblk = N / 64, kb = item / nblk, nb = item % nblk, k0 = 64 * kb, n0 = 64 * nb;
    const int lr = lane >> 4, lc = (lane & 15) * 4;
    f32x4 v[16];
#pragma unroll
    for (int i = 0; i < 16; ++i) v[i] = *(const GAS f32x4*)(W + (size_t)(k0 + 4 * i + lr) * N + n0 + lc);
#pragma unroll
    for (int i = 0; i < 16; ++i) { LAS float* d = scr + (4 * i + lr) * 65 + lc; d[0] = v[i][0]; d[1] = v[i][1]; d[2] = v[i][2]; d[3] = v[i][3]; }
    LDS_WAIT(); asm volatile("" ::: "memory");
    const int c = lane & 7;
#pragma unroll
    for (int j = 0; j < 8; ++j) { const int n = (lane >> 3) + 8 * j; const LAS float* s = scr + (8 * c) * 65 + n;
        v4u o; o.x = pk2(s[0 * 65], s[1 * 65]); o.y = pk2(s[2 * 65], s[3 * 65]); o.z = pk2(s[4 * 65], s[5 * 65]); o.w = pk2(s[6 * 65], s[7 * 65]);
        *(GAS v4u*)(WT + (size_t)dest_row<KIND>(n0 + n, row_off) * K + k0 + 8 * c) = o; }
    LDS_WAIT(); asm volatile("" ::: "memory");
}

__device__ __forceinline__ void p0_prologue(const Frame F) {
    const int tid = opaque_tid(), lane = tid & 63;
    const int gw = F.vcu * NWAVES + F.wave, NGW = F.G * NWAVES;
    const int gt = F.vcu * (NWAVES * 64) + tid, NGT = F.G * NWAVES * 64;
    LAS float* sl = (LAS float*)(F.lds);
    for (int i = tid; i < NGRP * DM; i += NWAVES * 64) { const int g = i / DM, k = i % DM; const float v = (g == 0) ? pin(F, I_CCTX)[k] : pin(F, I_C)[(g - 1) * DM + k]; sl[i] = silu_f(v); }
    __syncthreads();
    {
        float* part = (float*)(F.ws + WS_PART);
        for (int task = gw; task < DEPTH * 48 * KCH; task += NGW) {
            const int kc = task % KCH, cg = (task / KCH) % 48, l = task / (KCH * 48);
            const float* wp = pin(F, I_WADA) + ((size_t)l * DM + (size_t)kc * 64) * MODW + cg * 256 + lane * 4;
            f32x4 acc[NGRP];
#pragma unroll
            for (int g = 0; g < NGRP; ++g) acc[g] = (f32x4){0.f, 0.f, 0.f, 0.f};
            for (int k16 = 0; k16 < 64; k16 += 16) {
                f32x4 w[16];
#pragma unroll
                for (int q = 0; q < 16; ++q) w[q] = *(const GAS f32x4*)(wp + (size_t)(k16 + q) * MODW);
#pragma unroll
                for (int q4 = 0; q4 < 16; q4 += 4)
#pragma unroll
                    for (int g = 0; g < NGRP; ++g) { const f32x4 s = *(const LAS f32x4*)(sl + g * DM + kc * 64 + k16 + q4);
                        acc[g] += w[q4 + 0] * s[0]; acc[g] += w[q4 + 1] * s[1]; acc[g] += w[q4 + 2] * s[2]; acc[g] += w[q4 + 3] * s[3]; }
            }
#pragma unroll
            for (int g = 0; g < NGRP; ++g) *(f32x4*)(part + (((size_t)kc * DEPTH + l) * NGRP + g) * MODW + cg * 256 + lane * 4) = acc[g];
        }
    }
    {
        __syncthreads();
        LAS float* scr = (LAS float*)(F.lds + F.wave * 16640);
        constexpr int I_IN = (DM / 64) * (IN_COLS / 64), I_O = (DM / 64) * (DM / 64), I_G = (DM / 64) * (DFF / 64), I_D = (DFF / 64) * (DM / 64), I_UK = (256 / 64) * (1024 / 64);
        constexpr int PER_L = I_IN + I_O + 2 * I_G + I_D + 2 * I_UK;
        struct TrDesc { const float* W; bf16* WT; unsigned char* W8; int K, N, kind, row_off, k0, n0; };
        auto decode = [&](int it) -> TrDesc {
            TrDesc t; const int l = it / PER_L; int r = it % PER_L;
            t.W8 = (unsigned char*)(F.ws + WS_WIN8 + (size_t)l * SZ_WIN8);
            if (r < I_IN) { t.W = pin(F, I_WIN) + (size_t)l * DM * IN_COLS; t.WT = (bf16*)(F.ws + WS_WIN + (size_t)l * SZ_WIN); t.K = DM; t.N = IN_COLS; t.kind = 1; t.row_off = 0; }
            else if ((r -= I_IN) < I_O) { t.W = pin(F, I_WO) + (size_t)l * DM * DM; t.WT = (bf16*)(F.ws + WS_WO + (size_t)l * SZ_WO); t.W8 = (unsigned char*)(F.ws + WS_WO8 + (size_t)l * SZ_WO8); t.K = DM; t.N = DM; t.kind = 4; t.row_off = 0; }
            else if ((r -= I_O) < I_G) { t.W = pin(F, I_WG) + (size_t)l * DM * DFF; t.WT = (bf16*)(F.ws + WS_WGU + (size_t)l * SZ_WGU); t.K = DM; t.N = DFF; t.kind = 2; t.row_off = 0; }
            else if ((r -= I_G) < I_G) { t.W = pin(F, I_WU) + (size_t)l * DM * DFF; t.WT = (bf16*)(F.ws + WS_WGU + (size_t)l * SZ_WGU); t.K = DM; t.N = DFF; t.kind = 3; t.row_off = 0; }
            else if ((r -= I_G) < I_D) { t.W = pin(F, I_WD) + (size_t)l * DFF * DM; t.WT = (bf16*)(F.ws + WS_WD + (size_t)l * SZ_WD); t.K = DFF; t.N = DM; t.kind = 0; t.row_off = 0; }
            else if ((r -= I_D) < I_UK) { t.W = pin(F, I_WUK) + (size_t)l * 256 * 1024; t.WT = (bf16*)(F.ws + WS_WUKV + (size_t)l * SZ_WUKV); t.K = 256; t.N = 1024; t.kind = 0; t.row_off = 0; }
            else { r -= I_UK; t.W = pin(F, I_WUV) + (size_t)l * 256 * 1024; t.WT = (bf16*)(F.ws + WS_WUKV + (size_t)l * SZ_WUKV); t.K = 256; t.N = 1024; t.kind = 0; t.row_off = 1024; }
            const int nblk = t.N >> 6; t.k0 = 64 * (r / nblk); t.n0 = 64 * (r % nblk); return t;
        };
        const int lr = lane >> 4, lc = (lane & 15) * 4, c8 = lane & 7;
#define TR_LOAD(T, V) do { _Pragma("unroll") for (int i_ = 0; i_ < 16; ++i_) V[i_] = *(const GAS f32x4*)((T).W + (size_t)((T).k0 + 4 * i_ + lr) * (T).N + (T).n0 + lc); } while (0)
#define TR_FINISH(T, V) do { \
        _Pragma("unroll") for (int i_ = 0; i_ < 16; ++i_) { LAS float* d_ = scr + (4 * i_ + lr) * 65 + lc; d_[0] = V[i_][0]; d_[1] = V[i_][1]; d_[2] = V[i_][2]; d_[3] = V[i_][3]; } \
        LDS_WAIT(); asm volatile("" ::: "memory"); \
        _Pragma("unroll") for (int j_ = 0; j_ < 8; ++j_) { const int n_ = (T).n0 + (lane >> 3) + 8 * j_; const LAS float* s_ = scr + (8 * c8) * 65 + (lane >> 3) + 8 * j_; \
            const int dr_ = (T).kind == 1 ? win_dest(n_) : (T).kind == 2 ? ((n_ >> 7) << 8) + (n_ & 127) : (T).kind == 3 ? ((n_ >> 7) << 8) + 128 + (n_ & 127) : n_ + (T).row_off; \
            *(GAS v4u*)((T).WT + (size_t)dr_ * (T).K + (T).k0 + 8 * c8) = (v4u){pk2(s_[0 * 65], s_[1 * 65]), pk2(s_[2 * 65], s_[3 * 65]), pk2(s_[4 * 65], s_[5 * 65]), pk2(s_[6 * 65], s_[7 * 65])}; \
            if ((T).kind == 1 || (T).kind == 4) *(GAS v2u*)((GAS unsigned char*)(T).W8 + (size_t)dr_ * (T).K + (T).k0 + 8 * c8) = pg8::pk8_fp8(32.f * s_[0 * 65], 32.f * s_[1 * 65], 32.f * s_[2 * 65], 32.f * s_[3 * 65], 32.f * s_[4 * 65], 32.f * s_[5 * 65], 32.f * s_[6 * 65], 32.f * s_[7 * 65]);     } \
        LDS_WAIT(); asm volatile("" ::: "memory"); } while (0)
        {
            constexpr int NIT = DEPTH * PER_L;
            f32x4 va[16], vb[16]; TrDesc ta, tb; int it = gw;
            if (it < NIT) { ta = decode(it); TR_LOAD(ta, va); }
            while (it < NIT) {
                const int it1 = it + NGW, it2 = it + 2 * NGW;
                if (it1 < NIT) { tb = decode(it1); TR_LOAD(tb, vb); }
                TR_FINISH(ta, va);
                if (it1 >= NIT) break;
                if (it2 < NIT) { ta = decode(it2); TR_LOAD(ta, va); }
                TR_FINISH(tb, vb);
                it = it2;
            }
        }
#undef TR_LOAD
#undef TR_FINISH
        for (int i = gt; i < DEPTH * 49152; i += NGT) { const int l = i / 49152, q = i % 49152;
            *(GAS v4u*)((bf16*)(F.ws + WS_WIN + (size_t)l * SZ_WIN) + (size_t)IN_COLS * DM + (size_t)q * 8) = (v4u){0u, 0u, 0u, 0u}; }
    }
    for (int i = gt; i < DEPTH * 4 * 256 * 104; i += NGT) {
        const int q = i % 104, row = i / 104, j = row & 255, b = (row >> 8) & 3, l = row >> 10;
        const size_t krow = (size_t)NCTX + (size_t)b * 2304 + j, src_row = ((size_t)b * DEPTH + l) * 256 + j;
        if (q < 32) { const int h = q >> 4, p0 = (q & 15) * 8, i0 = p0 >> 1; const float* s = pin(F, I_CKA) + (src_row * 2 + h) * 128;
            const f32x4 lo = *(const f32x4*)(s + i0), hi = *(const f32x4*)(s + 64 + i0);
            *(GAS v2u*)((GAS unsigned char*)(F.ws + WS_KA + (size_t)l * SZ_KA) + krow * 256 + h * 128 + p0) = pg8::pk8_fp8(lo[0], hi[0], lo[1], hi[1], lo[2], hi[2], lo[3], hi[3]); }
        else if (q < 96) { const bool isv = q < 64; const int c0 = (isv ? q - 32 : q - 64) * 8; const float* s = (isv ? pin(F, I_CVA) : pin(F, I_CCKV)) + src_row * 256 + c0;
            const f32x4 a = *(const f32x4*)s, c = *(const f32x4*)(s + 4);
            if (isv) *(GAS v2u*)((GAS unsigned char*)(F.ws + WS_VA + (size_t)l * SZ_KA) + krow * 256 + c0) = pg8::pk8_fp8(a[0], a[1], a[2], a[3], c[0], c[1], c[2], c[3]);
            else *(GAS v4u*)((bf16*)(F.ws + WS_CKV + (size_t)l * SZ_KA) + krow * 256 + c0) = (v4u){pk2(a[0], a[1]), pk2(a[2], a[3]), pk2(c[0], c[1]), pk2(c[2], c[3])}; }
        else { const int p0 = (q - 96) * 8, i0 = p0 >> 1; const float* s = pin(F, I_CKR) + src_row * 64;
            const f32x4 lo = *(const f32x4*)(s + i0), hi = *(const f32x4*)(s + 32 + i0);
            *(GAS v2u*)((GAS unsigned char*)(F.ws + WS_KR + (size_t)l * SZ_KR) + krow * 64 + p0) = pg8::pk8_fp8(lo[0], hi[0], lo[1], hi[1], lo[2], hi[2], lo[3], hi[3]); }
    }
}
__device__ __forceinline__ void p1_modreduce(const Frame F) {
    const int gt = F.vcu * (NWAVES * 64) + opaque_tid(), NGT = F.G * NWAVES * 64;
    const float* part = (const float*)(F.ws + WS_PART); float* mod = (float*)(F.ws + WS_MOD);
    for (int i = gt; i < DEPTH * NGRP * MODW / 4; i += NGT) {
        const int e4 = i % (MODW / 4), lg = i / (MODW / 4), l = lg / NGRP;
        f32x4 s = *(const f32x4*)(pin(F, I_BADA) + (size_t)l * MODW + e4 * 4);
        for (int kc = 0; kc < KCH; ++kc) s += *(const f32x4*)(part + ((size_t)kc * DEPTH * NGRP + lg) * MODW + e4 * 4);
        *(f32x4*)(mod + (size_t)lg * MODW + e4 * 4) = s;
    }
}
template <int MODE>
__device__ __forceinline__ void norm_phase(const Frame F, int l) {
    const int lane = opaque_tid() & 63;
    int gw = F.vcu * NWAVES + F.wave; asm volatile("" : "+s"(gw));
    const int NGW = F.G * NWAVES;
    bf16* X = (bf16*)(F.ws + WS_X); bf16* XN = (bf16*)(F.ws + WS_XN); const float* mod = (const float*)(F.ws + WS_MOD);
    for (int rb = gw; rb < MTOK / 8; rb += NGW) {
        const int r0 = rb * 8, grp = r0 < NCTX ? 0 : 1 + ((r0 - NCTX) >> 11);
        f32x4 a[8], s[8];
        if (MODE == 2) {
#pragma unroll
            for (int j = 0; j < 8; ++j) { a[j] = *(const f32x4*)(pin(F, I_NF) + 8 * lane + 512 * (j >> 1) + 4 * (j & 1)); s[j] = (f32x4){0.f, 0.f, 0.f, 0.f}; }
        } else {
            const float* md = mod + ((size_t)l * NGRP + grp) * MODW + (MODE == 1 ? 3 * DM : 0);
            const float* nw = pin(F, MODE == 1 ? I_NFFN : I_NATT) + (size_t)l * DM;
#pragma unroll
            for (int j = 0; j < 8; ++j) { const int c = 8 * lane + 512 * (j >> 1) + 4 * (j & 1); a[j] = *(const f32x4*)(nw + c) * (*(const f32x4*)(md + DM + c) + 1.0f); s[j] = *(const f32x4*)(md + c); }
        }
        for (int rr = 0; rr < 8; rr += 2) {
            f32x4 v[2][8];
#pragma unroll
            for (int q = 0; q < 2; ++q) { const int r = r0 + rr + q;
                if (MODE == 0 && l == 0) {
                    const float* src = r < NCTX ? pin(F, I_XP) + (size_t)r * DM : pin(F, I_XS) + (size_t)(r - NCTX) * DM;
#pragma unroll
                    for (int j = 0; j < 8; ++j) v[q][j] = *(const f32x4*)(src + 8 * lane + 512 * (j >> 1) + 4 * (j & 1));
                } else {
#pragma unroll
                    for (int j = 0; j < 4; ++j) { const v4u w = *(const v4u*)(X + (size_t)r * DM + 8 * lane + 512 * j);
                        v[q][2 * j] = (f32x4){__uint_as_float(w.x << 16), __uint_as_float(w.x & 0xffff0000u), __uint_as_float(w.y << 16), __uint_as_float(w.y & 0xffff0000u)};
                        v[q][2 * j + 1] = (f32x4){__uint_as_float(w.z << 16), __uint_as_float(w.z & 0xffff0000u), __uint_as_float(w.w << 16), __uint_as_float(w.w & 0xffff0000u)}; }
                } }
#pragma unroll
            for (int q = 0; q < 2; ++q) { const int r = r0 + rr + q; float ss = 0.f;
                if (MODE == 0 && l == 0) {
#pragma unroll
                    for (int j = 0; j < 4; ++j) *(v4u*)(X + (size_t)r * DM + 8 * lane + 512 * j) = (v4u){pk2(v[q][2 * j][0], v[q][2 * j][1]), pk2(v[q][2 * j][2], v[q][2 * j][3]), pk2(v[q][2 * j + 1][0], v[q][2 * j + 1][1]), pk2(v[q][2 * j + 1][2], v[q][2 * j + 1][3])};
                }
#pragma unroll
                for (int j = 0; j < 8; ++j) ss += (v[q][j][0] * v[q][j][0] + v[q][j][1] * v[q][j][1]) + (v[q][j][2] * v[q][j][2] + v[q][j][3] * v[q][j][3]);
                const float rstd = 1.0f / sqrtf(wave_sum(ss, lane) * (1.0f / DM) + 1e-6f);
                if (MODE == 2) {
#pragma unroll
                    for (int j = 0; j < 8; ++j) *(f32x4*)((float*)pin(F, 23) + OUT_Y + (size_t)r * DM + 8 * lane + 512 * (j >> 1) + 4 * (j & 1)) = v[q][j] * rstd * a[j];
                } else {
#pragma unroll
                    for (int j = 0; j < 4; ++j) { const f32x4 y0 = v[q][2 * j] * rstd * a[2 * j] + s[2 * j], y1 = v[q][2 * j + 1] * rstd * a[2 * j + 1] + s[2 * j + 1];
                        *(v4u*)(XN + (size_t)r * DM + 8 * lane + 512 * j) = (v4u){pk2(y0[0], y0[1]), pk2(y0[2], y0[3]), pk2(y1[0], y1[1]), pk2(y1[2], y1[3])};
                        if (MODE == 0) *(GAS v2u*)((GAS unsigned char*)(F.ws + WS_XN8) + (size_t)r * DM + 8 * lane + 512 * j) = pg8::pk8_fp8(y0[0], y0[1], y0[2], y0[3], y1[0], y1[1], y1[2], y1[3]); }
                } }
        }
    }
}
__device__ __forceinline__ void attn_phase(const Frame F, int l) {
    const unsigned char* Qa = (const unsigned char*)(F.ws + WS_QA); const unsigned char* Qbn = (const unsigned char*)(F.ws + WS_QBN); const unsigned char* Qbr = (const unsigned char*)(F.ws + WS_QBR);
    const unsigned char* Ka = (const unsigned char*)(F.ws + WS_KA + (size_t)l * SZ_KA); const unsigned char* Kr = (const unsigned char*)(F.ws + WS_KR + (size_t)l * SZ_KR); const unsigned char* Kbn = (const unsigned char*)(F.ws + WS_KBN);
    const unsigned char* Va = (const unsigned char*)(F.ws + WS_VA + (size_t)l * SZ_KA); const unsigned char* Vb = (const unsigned char*)(F.ws + WS_VB);
    bf16* O = (bf16*)(F.ws + WS_O); unsigned char* O8 = (unsigned char*)(F.ws + WS_XN8);
    LAS char* lds = (LAS char*)(F.lds + RING_OFF);
    for (int pass = 0; pass < 2; ++pass)
        for (int u = F.vcu; u < 256; u += F.G) {
            const int h = pass == 0 ? ((u >> 3) & 7) : (u & 7);
            const size_t r0 = pass == 0 ? (size_t)NCTX + (size_t)(u >> 6) * 2048 + (size_t)(u & 7) * 256 : (size_t)(u >> 3) * 256;
            const size_t k0 = pass == 0 ? (size_t)NCTX + (size_t)(u >> 6) * 2304 : r0;
            const int seq = pass == 0 ? 2304 : 256;
            att::attn_unit<true, 1024, 2>(Qbn + r0 * 1024 + h * 128, Qbr + r0 * 512 + h * 64, Kbn + k0 * 1024 + h * 128, Kr + k0 * 64, Vb + k0 * 1024 + h * 128, O + r0 * 2048 + 1024 + h * 128, O8 + r0 * 2048 + 1024 + h * 128, pass == 0 && F.G == 256, seq, lds);
        }
    for (int pass = 0; pass < 2; ++pass)
        for (int u = F.vcu; u < 256; u += F.G) {
            const int h = pass == 0 ? ((u >> 3) & 7) : (u & 7);
            const size_t r0 = pass == 0 ? (size_t)NCTX + (size_t)(u >> 6) * 2048 + (size_t)(u & 7) * 256 : (size_t)(u >> 3) * 256;
            const size_t k0 = pass == 0 ? (size_t)NCTX + (size_t)(u >> 6) * 2304 : r0;
            const int seq = pass == 0 ? 2304 : 256;
            att::attn_unit<false, 256, 2>(Qa + r0 * 1024 + h * 128, nullptr, Ka + k0 * 256 + (h >> 2) * 128, nullptr, Va + k0 * 256 + (h >> 2) * 128, O + r0 * 2048 + h * 128, O8 + r0 * 2048 + h * 128, pass == 0 && F.G == 256, seq, lds);
        }
}

enum { PH_PRO = 0, PH_MOD = 1, PH_L0 = 2, PH_PER_L = 8, PH_FINAL = PH_L0 + PH_PER_L * DEPTH, N_PH = PH_FINAL + 1 };
__global__ void __launch_bounds__(NWAVES * 64, 2) mk_fwd(Args args) {
    extern __shared__ __attribute__((aligned(16))) unsigned char lds[];
    Frame F;
    F.lds = (LAS unsigned char*)lds;
    volatile LAS unsigned* MISC = (volatile LAS unsigned*)(F.lds + MISC_OFF);
    F.wave = __builtin_amdgcn_readfirstlane((int)threadIdx.x >> 6);
    F.G = gridDim.x; { const int bx = blockIdx.x; F.vcu = (F.G % 8 == 0) ? (bx % 8) * (F.G / 8) + bx / 8 : bx; }
    F.ws = (GAS unsigned char*)args.ws;
    for (int u = threadIdx.x; u < (LDS_BYTES - MISC_OFF) / 4; u += NWAVES * 64) ((LAS unsigned*)(F.lds + MISC_OFF))[u] = 0u;
    __syncthreads();
    const int lo = args.ph_lo, hi = args.ph_hi;
    unsigned* barw = (unsigned*)(args.ws + WS_CTL) + CW_BAR;
    XcdBarrier bar; bar.bar = barw; bar.x = 0; bar.st = nullptr;
    if (hi - lo > 1) bar = xcd_barrier_post(barw, MISC + 8);
#define IN(k) (lo <= (k) && (k) < hi)
#define SEAM(k) do { if (IN(k) && IN((k) + 1)) { XcdBarrier b_ = bar; GAS unsigned* bw_ = (GAS unsigned*)b_.bar; volatile LAS unsigned* st_ = b_.st; \
    asm volatile("" : "+s"(bw_), "+s"(b_.x), "+s"(st_)); b_.bar = (unsigned*)bw_; b_.st = st_; xcd_barrier(b_); } } while (0)

    if (IN(PH_PRO)) p0_prologue(fresh(F));
    SEAM(PH_PRO);
    if (IN(PH_MOD)) p1_modreduce(fresh(F));
    SEAM(PH_MOD);
    for (int l = 0; l < DEPTH; ++l) {
        const int pb = PH_L0 + PH_PER_L * l;
        if (IN(pb + 0)) norm_phase<0>(fresh(F), l);
        SEAM(pb + 0);
        if (IN(pb + 1)) {
            const Frame P = fresh(F);
            if (P.G == 256) {
                const int bx = (int)blockIdx.x;
#ifdef MK_SKEW_IN
                if ((bx >> 3) < 24 && ((bx >> 3) & 1)) __builtin_amdgcn_s_sleep(MK_SKEW_IN);
#endif
                { pg8::Gemm g{(const bf16*)(P.ws + WS_XN), (const bf16*)(P.ws + WS_WIN + (size_t)l * SZ_WIN), MTOK, INP, DM}; pg8::InOrderB S{bx & 7, bx >> 3};
                  pg8::EpiIn E; E.lds = P.lds; E.ws = P.ws; E.l = l; E.pn_base = 0;
                  pg8::gemm_phase<pg8::EpiIn, pg8::InOrderB, true, true>(P.lds + RING_OFF, g, S, E); }
                if ((bx >> 3) >= 24) {
                    int kukv = 256; asm volatile("" : "+s"(kukv));
                    pg8::Gemm g{(const bf16*)(P.ws + WS_CKV + (size_t)l * SZ_KA), (const bf16*)(P.ws + WS_WUKV + (size_t)l * SZ_WUKV), KROWS, 2048, kukv}; pg8::UkvOrder S{bx & 7, (bx >> 3) - 24, 0};
                    pg8::EpiUkv E{(unsigned char*)(P.ws + WS_KBN), (unsigned char*)(P.ws + WS_VB)};
                    pg8::gemm_phase<pg8::EpiUkv, pg8::UkvOrder, true, true>(P.lds + RING_OFF, g, S, E);
                }
                { pg8::Gemm g{(const bf16*)(P.ws + WS_XN8), (const bf16*)(P.ws + WS_WIN8 + (size_t)l * SZ_WIN8), MTOK, INP, DM}; pg8::InOrderQ S{bx & 7, bx >> 3};
                  pg8::EpiIn E; E.lds = P.lds; E.ws = P.ws; E.l = l; E.pn_base = 0;
                  pg8::gemm_phase<pg8::EpiIn, pg8::InOrderQ, true, true, true, 0x7A7A7A7A, 0x7F7F7F7F>(P.lds + RING_OFF, g, S, E); }
                if ((bx & 7) >= 4 && (bx >> 3) < 8) {
                    int kukv = 256; asm volatile("" : "+s"(kukv));
                    pg8::Gemm g{(const bf16*)(P.ws + WS_CKV + (size_t)l * SZ_KA), (const bf16*)(P.ws + WS_WUKV + (size_t)l * SZ_WUKV), KROWS, 2048, kukv}; pg8::UkvOrder S{bx & 7, bx >> 3, 1};
                    pg8::EpiUkv E{(unsigned char*)(P.ws + WS_KBN), (unsigned char*)(P.ws + WS_VB)};
                    pg8::gemm_phase<pg8::EpiUkv, pg8::UkvOrder, true, true>(P.lds + RING_OFF, g, S, E);
                }
            } else {
                { pg8::Gemm g{(const bf16*)(P.ws + WS_XN), (const bf16*)(P.ws + WS_WIN + (size_t)l * SZ_WIN), MTOK, INP, DM}; pg8::StaticOrder S; S.init(MTOK, INP, P.G, (int)blockIdx.x);
                  pg8::EpiIn E; E.lds = P.lds; E.ws = P.ws; E.l = l; E.pn_base = 0;
                  pg8::gemm_phase<pg8::EpiIn, pg8::StaticOrder, true, true>(P.lds + RING_OFF, g, S, E); }
            }
        }
        SEAM(pb + 1);
        if (IN(pb + 2)) {
            const Frame P = fresh(F);
            if (P.G != 256) {
                int kukv = 256; asm volatile("" : "+s"(kukv));
                pg8::Gemm g{(const bf16*)(P.ws + WS_CKV + (size_t)l * SZ_KA), (const bf16*)(P.ws + WS_WUKV + (size_t)l * SZ_WUKV), KROWS, 2048, kukv}; pg8::StaticOrder S; S.init(KROWS, 2048, P.G, (int)blockIdx.x);
                pg8::EpiUkv E{(unsigned char*)(P.ws + WS_KBN), (unsigned char*)(P.ws + WS_VB)};
                pg8::gemm_phase<pg8::EpiUkv, pg8::StaticOrder, true, true>(P.lds + RING_OFF, g, S, E);
            }
        }
        if (F.G != 256) SEAM(pb + 2);
        if (IN(pb + 3)) attn_phase(fresh(F), l);
        SEAM(pb + 3);
        if (IN(pb + 4)) {
            const Frame P = fresh(F);
            pg8::EpiRes E{(bf16*)(P.ws + WS_X), (const float*)(P.ws + WS_MOD) + (size_t)l * NGRP * MODW + 2 * DM};
            if (P.G == 256) {
                const int bx = (int)blockIdx.x;
                { pg8::Gemm g{(const bf16*)(P.ws + WS_XN8), (const bf16*)(P.ws + WS_WO8 + (size_t)l * SZ_WO8), MTOK, DM, DM}; pg8::HalfOrder S{bx & 7, bx >> 3, 1};
                  pg8::gemm_phase<pg8::EpiRes, pg8::HalfOrder, true, true, true, 0x7A7A7A7A, 0x7B7B7B7B>(P.lds + RING_OFF, g, S, E); }
                { pg8::Gemm g{(const bf16*)(P.ws + WS_O), (const bf16*)(P.ws + WS_WO + (size_t)l * SZ_WO), MTOK, DM, DM}; pg8::HalfOrder S{bx & 7, bx >> 3, 0};
                  pg8::gemm_phase<pg8::EpiRes, pg8::HalfOrder, true, true>(P.lds + RING_OFF, g, S, E); }
            } else {
                pg8::Gemm g{(const bf16*)(P.ws + WS_O), (const bf16*)(P.ws + WS_WO + (size_t)l * SZ_WO), MTOK, DM, DM}; pg8::StaticOrder S; S.init(MTOK, DM, P.G, (int)blockIdx.x);
                pg8::gemm_phase<pg8::EpiRes, pg8::StaticOrder, true, true>(P.lds + RING_OFF, g, S, E);
            }
        }
        SEAM(pb + 4);
        if (IN(pb + 5)) norm_phase<1>(fresh(F), l);
        SEAM(pb + 5);
        if (IN(pb + 6)) {
            const Frame P = fresh(F);
            pg8::Gemm g{(const bf16*)(P.ws + WS_XN), (const bf16*)(P.ws + WS_WGU + (size_t)l * SZ_WGU), MTOK, NGU, DM}; pg8::StaticOrder S; S.init(MTOK, NGU, P.G, (int)blockIdx.x);
            pg8::EpiSwiglu E{(bf16*)(P.ws + WS_H)};
            { const int g_ = ((int)blockIdx.x >> 3) & 3; if (g_ == 1) __builtin_amdgcn_s_sleep(16); else if (g_ == 2) __builtin_amdgcn_s_sleep(32); else if (g_ == 3) __builtin_amdgcn_s_sleep(48); }
            pg8::gemm_phase<pg8::EpiSwiglu, pg8::StaticOrder, true, true>(P.lds + RING_OFF, g, S, E);
        }
        SEAM(pb + 6);
        if (IN(pb + 7)) {
            const Frame P = fresh(F);
            pg8::Gemm g{(const bf16*)(P.ws + WS_H), (const bf16*)(P.ws + WS_WD + (size_t)l * SZ_WD), MTOK, DM, DFF}; pg8::StaticOrder S; S.init(MTOK, DM, P.G, (int)blockIdx.x);
            pg8::EpiRes E{(bf16*)(P.ws + WS_X), (const float*)(P.ws + WS_MOD) + (size_t)l * NGRP * MODW + 5 * DM};
            pg8::gemm_phase<pg8::EpiRes, pg8::StaticOrder, true, true>(P.lds + RING_OFF, g, S, E);
        }
        SEAM(pb + 7);
    }
    if (IN(PH_FINAL)) norm_phase<2>(fresh(F), 0);
#undef IN
#undef SEAM
}

#ifndef MK_ONE_LAUNCH
#define MK_ONE_LAUNCH 1
#endif
extern "C" void kernel_launch(void* const* d_in, const int* in_sizes, int n_in, void* d_out, int out_size, void* d_ws, size_t ws_size, hipStream_t stream) {
    static int grid = 0;
    if (grid == 0) {
        if (n_in != 23 || (size_t)out_size != OUT_TOTAL || ws_size < WS_END) { fprintf(stderr, "kernel_launch: shape mismatch: n_in %d out %d ws %zu (need %zu)\n", n_in, out_size, ws_size, (size_t)WS_END); grid = -1; return; }
        int dev = 0, cus = 0, per_cu = 0;
        if (hipGetDevice(&dev) != hipSuccess || hipDeviceGetAttribute(&cus, hipDeviceAttributeMultiprocessorCount, dev) != hipSuccess) { grid = -1; return; }
        if (hipFuncSetAttribute((const void*)mk_fwd, hipFuncAttributeMaxDynamicSharedMemorySize, LDS_BYTES) != hipSuccess) { fprintf(stderr, "kernel_launch: hipFuncSetAttribute failed\n"); grid = -1; return; }
        if (hipOccupancyMaxActiveBlocksPerMultiprocessor(&per_cu, (const void*)mk_fwd, NWAVES * 64, LDS_BYTES) != hipSuccess || per_cu < 1) fprintf(stderr, "kernel_launch: occupancy query reports %d\n", per_cu);
        (void)hipGetLastError();
        grid = cus;
    }
    if (grid < 0) return;
    if (hipMemsetAsync((char*)d_ws + WS_CTL, 0, CTL_ZERO_BYTES, stream) != hipSuccess) return;
    Args a{};
    for (int i = 0; i < 23; ++i) a.in[i] = (const float*)d_in[i];
    a.out = (float*)d_out; a.ws = (unsigned char*)d_ws;
#if MK_ONE_LAUNCH
    a.ph_lo = 0; a.ph_hi = N_PH;
    hipLaunchKernelGGL(mk_fwd, dim3(grid), dim3(NWAVES * 64), LDS_BYTES, stream, a);
#else
    for (int p = 0; p < N_PH; ++p) { a.ph_lo = p; a.ph_hi = p + 1; hipLaunchKernelGGL(mk_fwd, dim3(grid), dim3(NWAVES * 64), LDS_BYTES, stream, a); }
#endif
    const hipError_t le = hipPeekAtLastError();
    if (le != hipSuccess) fprintf(stderr, "kernel_launch: launch failed: %s\n", hipGetErrorName(le));
}
```
